# Optimizing an MI355X kernel written in HIP

```python
import math
import jax, jax.numpy as jnp
from jax import lax
import numpy as np

D_MODEL = 1024
BATCH = 32
SEQ = 2048
DEPTH = 4

GRID_W = 64
CTX_LEN = 256
N_MIXERS = 2
HEAD_DIM = 64
N_HEADS = D_MODEL // HEAD_DIM
A_KV_HEADS = 4
A_GROUPS = N_HEADS // A_KV_HEADS
A_WINDOW = 128
A_BLOCK = 128
A_INNER = N_HEADS * HEAD_DIM
A_KV_DIM = A_KV_HEADS * HEAD_DIM
A_IN_DIM = 2 * A_INNER + 2 * A_KV_DIM
B_KH_MAX = 8
B_KW = 16
B_QW = 16
B_REG_W = 2 * B_KW
B_INNER = N_HEADS * HEAD_DIM
B_IN_DIM = 4 * B_INNER
ROPE_BASE = 10000.0
LN_EPS = 1e-5
NEG_INF = -1e30
DEEPNORM_ALPHA = (2.0 * DEPTH) ** 0.25
DEEPNORM_BETA = (8.0 * DEPTH) ** -0.25
N_LAYERS_A = (DEPTH + 1) // 2
N_LAYERS_B = DEPTH // 2

kernel_name = "hybrid_window_gqa_neighbourhood_diffusion_trunk"


def layer_norm(x, g, b):
    xf = x.astype(jnp.float32)
    mu = jnp.mean(xf, axis=-1, keepdims=True)
    var = jnp.mean(jnp.square(xf - mu), axis=-1, keepdims=True)
    y = (xf - mu) * lax.rsqrt(var + LN_EPS)
    return (y * g.astype(jnp.float32) + b.astype(jnp.float32)).astype(x.dtype)


def axial_rope_tables(n_tok):
    t = jnp.arange(n_tok)
    row = (t // GRID_W).astype(jnp.float32)
    col = (t % GRID_W).astype(jnp.float32)
    n_freq = HEAD_DIM // 4
    inv = ROPE_BASE ** (-jnp.arange(n_freq, dtype=jnp.float32) / n_freq)
    ang_r = row[:, None] * inv[None]
    ang_c = col[:, None] * inv[None]
    return (jnp.cos(ang_r), jnp.sin(ang_r), jnp.cos(ang_c), jnp.sin(ang_c))


def _rotate(x, cos, sin):
    a, b = jnp.split(x, 2, axis=-1)
    cos = cos[None, :, None, :].astype(x.dtype)
    sin = sin[None, :, None, :].astype(x.dtype)
    return jnp.concatenate([a * cos - b * sin, b * cos + a * sin], axis=-1)


def apply_axial_rope(x, rope):
    cos_r, sin_r, cos_c, sin_c = rope
    xr, xc = jnp.split(x, 2, axis=-1)
    return jnp.concatenate([_rotate(xr, cos_r, sin_r), _rotate(xc, cos_c, sin_c)], axis=-1)


def ctx_attention(q, k, v, sink):
    B, C = q.shape[0], q.shape[1]
    s = jnp.einsum('bqkgd,bckd->bkgqc', q, k).astype(jnp.float32) * (HEAD_DIM ** -0.5)
    if sink is not None:
        s_sink = jnp.broadcast_to(sink[None, :, :, None, None], s.shape[:-1] + (1,))
        p = jax.nn.softmax(jnp.concatenate([s, s_sink], axis=-1), axis=-1)[..., :C]
    else:
        p = jax.nn.softmax(s, axis=-1)
    o = jnp.einsum('bkgqc,bckd->bqkgd', p.astype(v.dtype), v)
    return o.reshape(B, C, -1)


def _split_a(p):
    return jnp.split(p, [A_INNER, A_INNER + A_KV_DIM, A_INNER + 2 * A_KV_DIM], axis=-1)


def mixer_a(u, uc, w_in, w_out, sink, rope, ctx_out):
    B, S, _ = u.shape
    C = uc.shape[1]
    scale = HEAD_DIM ** -0.5
    q, k, v, g = _split_a(u @ w_in)
    q = apply_axial_rope(q.reshape(B, S, N_HEADS, HEAD_DIM), rope).reshape(B, S, A_KV_HEADS, A_GROUPS, HEAD_DIM)
    k = apply_axial_rope(k.reshape(B, S, A_KV_HEADS, HEAD_DIM), rope)
    v = v.reshape(B, S, A_KV_HEADS, HEAD_DIM)
    qc, kc, vc, gc = _split_a(uc @ w_in)
    kc = kc.reshape(B, C, A_KV_HEADS, HEAD_DIM)
    vc = vc.reshape(B, C, A_KV_HEADS, HEAD_DIM)
    sink_l = sink.reshape(A_KV_HEADS, A_GROUPS).astype(jnp.float32)
    span = A_BLOCK + 2 * A_WINDOW
    pad = ((0, 0), (A_WINDOW, A_WINDOW), (0, 0), (0, 0))
    kp = jnp.pad(k, pad)
    vp = jnp.pad(v, pad)

    def block(bi):
        start = bi * A_BLOCK
        qb = lax.dynamic_slice_in_dim(q, start, A_BLOCK, axis=1)
        kb = lax.dynamic_slice_in_dim(kp, start, span, axis=1)
        vb = lax.dynamic_slice_in_dim(vp, start, span, axis=1)
        qi = start + jnp.arange(A_BLOCK)
        kj = start - A_WINDOW + jnp.arange(span)
        mask = (jnp.abs(qi[:, None] - kj[None, :]) <= A_WINDOW) & (kj >= 0)[None, :] & (kj < S)[None, :]
        s_lat = jnp.einsum('bqkgd,bjkd->bkgqj', qb, kb).astype(jnp.float32) * scale
        s_lat = jnp.where(mask, s_lat, NEG_INF)
        s_ctx = jnp.einsum('bqkgd,bckd->bkgqc', qb, kc).astype(jnp.float32) * scale
        s_sink = jnp.broadcast_to(sink_l[None, :, :, None, None], s_lat.shape[:-1] + (1,))
        p = jax.nn.softmax(jnp.concatenate([s_lat, s_ctx, s_sink], axis=-1), axis=-1)
        p_lat = p[..., :span].astype(v.dtype)
        p_ctx = p[..., span:span + C].astype(v.dtype)
        o = jnp.einsum('bkgqj,bjkd->bqkgd', p_lat, vb) + jnp.einsum('bkgqc,bckd->bqkgd', p_ctx, vc)
        return o.reshape(B, A_BLOCK, A_INNER)

    o = lax.map(block, jnp.arange(S // A_BLOCK))
    o = jnp.transpose(o, (1, 0, 2, 3)).reshape(B, S, A_INNER)
    y = (o * jax.nn.silu(g)) @ w_out
    if not ctx_out:
        return y, None
    oc = ctx_attention(qc.reshape(B, C, A_KV_HEADS, A_GROUPS, HEAD_DIM), kc, vc, sink_l)
    yc = (oc * jax.nn.silu(gc)) @ w_out
    return y, yc


def mixer_b(u, uc, w_in, w_out, rel_bias, ctx_out):
    B, S, _ = u.shape
    C = uc.shape[1]
    rows = S // GRID_W
    kh = min(B_KH_MAX, rows)
    scale = HEAD_DIM ** -0.5
    q, k, v, g = jnp.split(u @ w_in, 4, axis=-1)
    q = q.reshape(B, rows, GRID_W, N_HEADS, HEAD_DIM)
    k = k.reshape(B, rows, GRID_W, N_HEADS, HEAD_DIM)
    v = v.reshape(B, rows, GRID_W, N_HEADS, HEAD_DIM)
    qc, kc, vc, gc = jnp.split(uc @ w_in, 4, axis=-1)
    kc = kc.reshape(B, C, N_HEADS, HEAD_DIM)
    vc = vc.reshape(B, C, N_HEADS, HEAD_DIM)

    n_cb = GRID_W // B_QW
    c0 = np.arange(n_cb) * B_QW
    cs_blk = np.clip(c0 - B_KW // 2, 0, GRID_W - B_REG_W)
    key_col = cs_blk[:, None] + np.arange(B_REG_W)
    q_col = c0[:, None] + np.arange(B_QW)
    cs_q = np.clip(q_col - B_KW // 2, 0, GRID_W - B_KW)
    col_mask = (key_col[:, None, :] >= cs_q[:, :, None]) & (key_col[:, None, :] < cs_q[:, :, None] + B_KW)
    col_idx = np.clip(key_col[:, None, :] - q_col[:, :, None] + (B_KW - 1), 0, 2 * B_KW - 2)
    key_col = jnp.asarray(key_col, dtype=jnp.int32)
    col_idx = jnp.asarray(col_idx, dtype=jnp.int32)
    col_mask = jnp.asarray(col_mask)[:, :, None, :]
    bias_tab = rel_bias.astype(jnp.float32)

    def row_block(r):
        rs = jnp.clip(r - kh // 2, 0, rows - kh)
        q_r = lax.dynamic_index_in_dim(q, r, axis=1, keepdims=False).reshape(B, n_cb, B_QW, N_HEADS, HEAD_DIM)
        k_rows = lax.dynamic_slice_in_dim(k, rs, kh, axis=1)
        v_rows = lax.dynamic_slice_in_dim(v, rs, kh, axis=1)
        k_reg = k_rows[:, :, key_col]
        v_reg = v_rows[:, :, key_col]
        s = jnp.einsum('bnqhd,brnjhd->bhnqrj', q_r, k_reg).astype(jnp.float32) * scale
        row_idx = rs + jnp.arange(kh) - r + (B_KH_MAX - 1)
        bias = bias_tab[:, row_idx[:, None, None, None], col_idx[None]]
        s = s + jnp.transpose(bias, (0, 2, 3, 1, 4))[None]
        s = jnp.where(col_mask, s, NEG_INF).reshape(B, N_HEADS, n_cb, B_QW, kh * B_REG_W)
        s_ctx = jnp.einsum('bnqhd,bchd->bhnqc', q_r, kc).astype(jnp.float32) * scale
        p = jax.nn.softmax(jnp.concatenate([s, s_ctx], axis=-1), axis=-1)
        p_lat = p[..., :kh * B_REG_W].reshape(B, N_HEADS, n_cb, B_QW, kh, B_REG_W).astype(v.dtype)
        p_ctx = p[..., kh * B_REG_W:].astype(v.dtype)
        o = jnp.einsum('bhnqrj,brnjhd->bnqhd', p_lat, v_reg) + jnp.einsum('bhnqc,bchd->bnqhd', p_ctx, vc)
        return o.reshape(B, GRID_W, B_INNER)

    o = lax.map(row_block, jnp.arange(rows))
    o = jnp.transpose(o, (1, 0, 2, 3)).reshape(B, S, B_INNER)
    y = (o * jax.nn.silu(g)) @ w_out
    if not ctx_out:
        return y, None
    oc = ctx_attention(qc.reshape(B, C, N_HEADS, 1, HEAD_DIM), kc[:, :, :, :], vc, None)
    yc = (oc * jax.nn.silu(gc)) @ w_out
    return y, yc


def setup_inputs(seed: int = 0) -> dict:
    key = jax.random.key(seed)
    ks = jax.random.split(key, 14)
    f32 = jnp.float32
    d = D_MODEL
    return {
        "x": jax.random.normal(ks[0], (BATCH, SEQ, d), f32),
        "c": jax.random.normal(ks[1], (BATCH, d), f32),
        "ctx": jax.random.normal(ks[2], (BATCH, CTX_LEN, d), f32),
        "c_ctx": jax.random.normal(ks[3], (d,), f32),
        "w_ada": jax.random.normal(ks[4], (DEPTH, d, 3 * d), f32) * d ** -0.5,
        "b_ada": 0.01 * jax.random.normal(ks[5], (DEPTH, 3 * d), f32),
        "ln_g": 1.0 + 0.05 * jax.random.normal(ks[6], (DEPTH, d), f32),
        "ln_b": 0.02 * jax.random.normal(ks[7], (DEPTH, d), f32),
        "a_w_in": jax.random.normal(ks[8], (N_LAYERS_A, d, A_IN_DIM), f32) * d ** -0.5,
        "a_w_out": jax.random.normal(ks[9], (N_LAYERS_A, A_INNER, d), f32) * (A_INNER ** -0.5 * DEEPNORM_BETA),
        "a_sink": 0.5 * jax.random.normal(ks[10], (N_LAYERS_A, N_HEADS), f32),
        "b_w_in": jax.random.normal(ks[11], (N_LAYERS_B, d, B_IN_DIM), f32) * d ** -0.5,
        "b_w_out": jax.random.normal(ks[12], (N_LAYERS_B, B_INNER, d), f32) * (B_INNER ** -0.5 * DEEPNORM_BETA),
        "b_rel_bias": 0.5 * jax.random.normal(ks[13], (N_LAYERS_B, N_HEADS, 2 * B_KH_MAX - 1, 2 * B_KW - 1), f32),
    }


def reference(x, c, ctx, c_ctx, w_ada, b_ada, ln_g, ln_b, a_w_in, a_w_out, a_sink, b_w_in, b_w_out, b_rel_bias):
    S = x.shape[1]
    rope = axial_rope_tables(S)
    silu_c = jax.nn.silu(c)
    silu_cc = jax.nn.silu(c_ctx)
    h, hc = x, ctx
    for i in range(DEPTH):
        shift, scale, gate = jnp.split(silu_c @ w_ada[i] + b_ada[i], 3, axis=-1)
        shift_c, scale_c, gate_c = jnp.split(silu_cc @ w_ada[i] + b_ada[i], 3, axis=-1)
        ctx_out = i < DEPTH - 1
        u = h * (1.0 + scale[:, None, :]) + shift[:, None, :]
        uc = hc * (1.0 + scale_c) + shift_c
        j = i // N_MIXERS
        if i % N_MIXERS == 0:
            y, yc = mixer_a(u, uc, a_w_in[j], a_w_out[j], a_sink[j], rope, ctx_out)
        else:
            y, yc = mixer_b(u, uc, b_w_in[j], b_w_out[j], b_rel_bias[j], ctx_out)
        h = layer_norm(DEEPNORM_ALPHA * h + gate[:, None, :] * y, ln_g[i], ln_b[i])
        if ctx_out:
            hc = layer_norm(DEEPNORM_ALPHA * hc + gate_c * yc, ln_g[i], ln_b[i])
    return h
```

```cpp
#include <hip/hip_runtime.h>
#include <hip/hip_cooperative_groups.h>
#include <cstdio>
namespace cg = cooperative_groups;

#ifndef MK_COOP
#define MK_COOP 0
#endif
#ifndef NAIVE_ATTN
#define NAIVE_ATTN 1
#endif

typedef unsigned short bf16_t;
typedef short bf16x8 __attribute__((ext_vector_type(8)));
typedef float f32x16 __attribute__((ext_vector_type(16)));
typedef float f32x2 __attribute__((ext_vector_type(2)));
typedef __bf16 bf16x2v __attribute__((ext_vector_type(2)));

#define DI __device__ __forceinline__

constexpr int NB = 32, SEQ = 2048, DM = 1024, CTXL = 256;
constexpr int TL = NB * SEQ;
constexpr int TC = NB * CTXL;
constexpr int TT = TL + TC;
constexpr int NPHASE = 18;
constexpr float ALPHA = 1.681792830507429f;
constexpr int SMEM_BYTES = 128 * 132 * 4;

DI unsigned pk2(float lo, float hi) { f32x2 v = {lo, hi}; return __builtin_bit_cast(unsigned, __builtin_convertvector(v, bf16x2v)); }
DI float bf2f(bf16_t x) { return __uint_as_float(((unsigned)x) << 16); }
DI float bflo(unsigned u) { return __uint_as_float(u << 16); }
DI float bfhi(unsigned u) { return __uint_as_float(u & 0xffff0000u); }
DI float silu_f(float x) { return x / (1.f + __expf(-x)); }
DI float wave_sum(float v) {
#pragma unroll
  for (int o = 32; o > 0; o >>= 1) v += __shfl_xor(v, o);
  return v;
}
DI float wave_max(float v) {
#pragma unroll
  for (int o = 32; o > 0; o >>= 1) v = fmaxf(v, __shfl_xor(v, o));
  return v;
}
DI int clampi(int x, int lo, int hi) { return x < lo ? lo : (x > hi ? hi : x); }

struct Params {
  const float *x, *c, *ctx, *c_ctx, *w_ada, *b_ada, *ln_g, *ln_b, *a_w_in, *a_w_out, *a_sink, *b_w_in, *b_w_out, *b_rel_bias;
  float* out;
  float* hc;
  bf16_t* u;
  bf16_t* qkvg;
  bf16_t* vt;
  bf16_t* vtc;
  bf16_t* wt_a_in;
  bf16_t* wt_a_out;
  bf16_t* wt_b_in;
  bf16_t* wt_b_out;
  float* mod;
  float* rope;
};

DI void prep_mod_item(const Params& p, int item, float* smem) {
  const int tid = threadIdx.x, lane = tid & 63, kg = tid >> 6;
  const int layer = item / 48, cgp = item % 48;
  const int col = cgp * 64 + lane;
  float acc[33];
#pragma unroll
  for (int b = 0; b < 33; ++b) acc[b] = 0.f;
  const float* W = p.w_ada + (size_t)layer * 1024 * 3072;
  for (int kc = 0; kc < 4; ++kc) {
    __syncthreads();
    for (int e = tid; e < 4 * 33 * 64; e += 256) {
      int kk = e & 63, b = (e >> 6) % 33, g = e / (64 * 33);
      int k = g * 256 + kc * 64 + kk;
      float v = (b < 32) ? p.c[b * 1024 + k] : p.c_ctx[k];
      smem[e] = silu_f(v);
    }
    __syncthreads();
    const float* sg = smem + kg * 33 * 64;
    for (int kk = 0; kk < 64; ++kk) {
      float w = W[(size_t)(kg * 256 + kc * 64 + kk) * 3072 + col];
#pragma unroll
      for (int b = 0; b < 33; ++b) acc[b] += sg[b * 64 + kk] * w;
    }
  }
  __syncthreads();
#pragma unroll
  for (int b = 0; b < 33; ++b) smem[(kg * 33 + b) * 64 + lane] = acc[b];
  __syncthreads();
  for (int e = tid; e < 33 * 64; e += 256) {
    int l = e & 63, b = e >> 6;
    float s = smem[(0 * 33 + b) * 64 + l] + smem[(1 * 33 + b) * 64 + l] + smem[(2 * 33 + b) * 64 + l] + smem[(3 * 33 + b) * 64 + l];
    int cc = cgp * 64 + l;
    p.mod[((size_t)layer * 33 + b) * 3072 + cc] = s + p.b_ada[layer * 3072 + cc];
  }
  __syncthreads();
}

DI void prep_transpose_item(const float* W, bf16_t* Wt, int N, int kt, int nt, float* smem) {
  const int tid = threadIdx.x;
  __syncthreads();
#pragma unroll
  for (int i = 0; i < 16; ++i) {
    int kl = i * 4 + (tid >> 6), nl = tid & 63;
    smem[kl * 65 + nl] = W[(size_t)(kt * 64 + kl) * N + nt * 64 + nl];
  }
  __syncthreads();
#pragma unroll
  for (int i = 0; i < 16; ++i) {
    int nl = i * 4 + (tid >> 6), kl = tid & 63;
    float v = smem[kl * 65 + nl];
    Wt[(size_t)(nt * 64 + nl) * 1024 + kt * 64 + kl] = (bf16_t)(pk2(v, 0.f) & 0xffffu);
  }
}

DI void phase_prep(const Params& p, float* smem) {
  const int n_ain = 2 * 16 * 40, n_aout = 2 * 16 * 16, n_bin = 2 * 16 * 64, n_bout = 2 * 16 * 16;
  const int total = 192 + n_ain + n_aout + n_bin + n_bout + 1;
  for (int item = blockIdx.x; item < total; item += gridDim.x) {
    int it = item;
    if (it < 192) { prep_mod_item(p, it, smem); continue; }
    it -= 192;
    if (it < n_ain) { int l = it / (16 * 40), r = it % (16 * 40); prep_transpose_item(p.a_w_in + (size_t)l * 1024 * 2560, p.wt_a_in + (size_t)l * 2560 * 1024, 2560, r / 40, r % 40, smem); continue; }
    it -= n_ain;
    if (it < n_aout) { int l = it / 256, r = it % 256; prep_transpose_item(p.a_w_out + (size_t)l * 1024 * 1024, p.wt_a_out + (size_t)l * 1024 * 1024, 1024, r / 16, r % 16, smem); continue; }
    it -= n_aout;
    if (it < n_bin) { int l = it / (16 * 64), r = it % (16 * 64); prep_transpose_item(p.b_w_in + (size_t)l * 1024 * 4096, p.wt_b_in + (size_t)l * 4096 * 1024, 4096, r / 64, r % 64, smem); continue; }
    it -= n_bin;
    if (it < n_bout) { int l = it / 256, r = it % 256; prep_transpose_item(p.b_w_out + (size_t)l * 1024 * 1024, p.wt_b_out + (size_t)l * 1024 * 1024, 1024, r / 16, r % 16, smem); continue; }
    for (int e = threadIdx.x; e < 64 * 16; e += 256) {
      int pos = e >> 4, j = e & 15;
      float inv = powf(10000.0f, -(float)j / 16.0f);
      float ang = (float)pos * inv;
      p.rope[e * 2 + 0] = cosf(ang);
      p.rope[e * 2 + 1] = sinf(ang);
    }
  }
}

DI void phase_mod0(const Params& p) {
  const size_t nchunk = (size_t)TT * 128;
  for (size_t ch = (size_t)blockIdx.x * 256 + threadIdx.x; ch < nchunk; ch += (size_t)gridDim.x * 256) {
    int row = (int)(ch >> 7), col = (int)(ch & 127) * 8;
    bool isctx = row >= TL;
    int b = isctx ? 32 : (row >> 11);
    const float* src = isctx ? (p.ctx + (size_t)(row - TL) * 1024 + col) : (p.x + (size_t)row * 1024 + col);
    const float* md = p.mod + (size_t)b * 3072;
    float4 v0 = *(const float4*)src, v1 = *(const float4*)(src + 4);
    float4 sh0 = *(const float4*)(md + col), sh1 = *(const float4*)(md + col + 4);
    float4 sc0 = *(const float4*)(md + 1024 + col), sc1 = *(const float4*)(md + 1024 + col + 4);
    uint4 o;
    o.x = pk2(v0.x * (1.f + sc0.x) + sh0.x, v0.y * (1.f + sc0.y) + sh0.y);
    o.y = pk2(v0.z * (1.f + sc0.z) + sh0.z, v0.w * (1.f + sc0.w) + sh0.w);
    o.z = pk2(v1.x * (1.f + sc1.x) + sh1.x, v1.y * (1.f + sc1.y) + sh1.y);
    o.w = pk2(v1.z * (1.f + sc1.z) + sh1.z, v1.w * (1.f + sc1.w) + sh1.w);
    *(uint4*)(p.u + (size_t)row * 1024 + col) = o;
  }
}

enum { EPI_A = 0, EPI_B = 1, EPI_OUT = 2 };

template <int EPI>
DI void gemm_phase(const Params& p, const bf16_t* __restrict__ A, int lda, const bf16_t* __restrict__ Wt, int M, int N, char* smem) {
  const int tid = threadIdx.x, lane = tid & 63, wave = tid >> 6;
  const int wm = wave >> 1, wn = wave & 1, r = lane & 31, h = lane >> 5;
  char* As = smem;
  char* Bs = smem + 128 * 144;
  float* Cs = (float*)smem;
  const int ntn = N / 128, ntm = M / 128;
  const int ntiles = ntn * ntm;
  for (int tile = blockIdx.x; tile < ntiles; tile += gridDim.x) {
    const int mt = tile / ntn, nt = tile % ntn;
    const int m0 = mt * 128, n0 = nt * 128;
    f32x16 acc[2][2];
#pragma unroll
    for (int i = 0; i < 2; ++i)
#pragma unroll
      for (int j = 0; j < 2; ++j)
#pragma unroll
        for (int v = 0; v < 16; ++v) acc[i][j][v] = 0.f;
    const bf16_t* Ag = A + (size_t)(m0 + (tid >> 3)) * lda + (tid & 7) * 8;
    const bf16_t* Bg = Wt + (size_t)(n0 + (tid >> 3)) * 1024 + (tid & 7) * 8;
    const size_t sa = (size_t)32 * lda, sb = (size_t)32 * 1024;
    uint4 ra0 = *(const uint4*)(Ag), ra1 = *(const uint4*)(Ag + sa), ra2 = *(const uint4*)(Ag + 2 * sa), ra3 = *(const uint4*)(Ag + 3 * sa);
    uint4 rb0 = *(const uint4*)(Bg), rb1 = *(const uint4*)(Bg + sb), rb2 = *(const uint4*)(Bg + 2 * sb), rb3 = *(const uint4*)(Bg + 3 * sb);
    char* Asw = As + (tid >> 3) * 144 + (tid & 7) * 16;
    char* Bsw = Bs + (tid >> 3) * 144 + (tid & 7) * 16;
#pragma unroll 1
    for (int kt = 0; kt < 16; ++kt) {
      __syncthreads();
      *(uint4*)(Asw) = ra0; *(uint4*)(Asw + 32 * 144) = ra1; *(uint4*)(Asw + 64 * 144) = ra2; *(uint4*)(Asw + 96 * 144) = ra3;
      *(uint4*)(Bsw) = rb0; *(uint4*)(Bsw + 32 * 144) = rb1; *(uint4*)(Bsw + 64 * 144) = rb2; *(uint4*)(Bsw + 96 * 144) = rb3;
      __syncthreads();
      if (kt + 1 < 16) {
        const bf16_t* Ak = Ag + (kt + 1) * 64;
        const bf16_t* Bk = Bg + (kt + 1) * 64;
        ra0 = *(const uint4*)(Ak); ra1 = *(const uint4*)(Ak + sa); ra2 = *(const uint4*)(Ak + 2 * sa); ra3 = *(const uint4*)(Ak + 3 * sa);
        rb0 = *(const uint4*)(Bk); rb1 = *(const uint4*)(Bk + sb); rb2 = *(const uint4*)(Bk + 2 * sb); rb3 = *(const uint4*)(Bk + 3 * sb);
      }
#pragma unroll
      for (int ks = 0; ks < 4; ++ks) {
        bf16x8 a[2], b[2];
#pragma unroll
        for (int i = 0; i < 2; ++i) a[i] = *(const bf16x8*)(As + (wm * 64 + i * 32 + r) * 144 + (ks * 16 + h * 8) * 2);
#pragma unroll
        for (int j = 0; j < 2; ++j) b[j] = *(const bf16x8*)(Bs + (wn * 64 + j * 32 + r) * 144 + (ks * 16 + h * 8) * 2);
#pragma unroll
        for (int i = 0; i < 2; ++i)
#pragma unroll
          for (int j = 0; j < 2; ++j) acc[i][j] = __builtin_amdgcn_mfma_f32_32x32x16_bf16(a[i], b[j], acc[i][j], 0, 0, 0);
      }
    }
    __syncthreads();
#pragma unroll
    for (int i = 0; i < 2; ++i)
#pragma unroll
      for (int j = 0; j < 2; ++j)
#pragma unroll
        for (int v = 0; v < 16; ++v) {
          int row = wm * 64 + i * 32 + (v & 3) + 8 * (v >> 2) + 4 * h;
          int col = wn * 64 + j * 32 + r;
          Cs[row * 132 + col] = acc[i][j][v];
        }
    __syncthreads();
    if (EPI == EPI_OUT) {
#pragma unroll 1
      for (int i = 0; i < 8; ++i) {
        int c = tid + i * 256, row = c >> 4, cc = (c & 15) * 8;
        const float* s = Cs + row * 132 + cc;
        uint4 o; o.x = pk2(s[0], s[1]); o.y = pk2(s[2], s[3]); o.z = pk2(s[4], s[5]); o.w = pk2(s[6], s[7]);
        *(uint4*)(p.u + (size_t)(m0 + row) * 1024 + n0 + cc) = o;
      }
    } else {
      const bool isA = (EPI == EPI_A);
      const bool isctx = m0 >= TL;
      const int qend = 1024, kend = isA ? 1280 : 2048, vend = isA ? 1536 : 3072;
      const int HKV = isA ? 4 : 16;
      if (n0 >= kend && n0 < vend) {
        const int b = isctx ? ((m0 - TL) >> 8) : (m0 >> 11);
        const int s0 = isctx ? ((m0 - TL) & 255) : (m0 & 2047);
        const int len = isctx ? 256 : 2048;
        bf16_t* base = isctx ? p.vtc : p.vt;
#pragma unroll 1
        for (int i = 0; i < 8; ++i) {
          int c = tid + i * 256, col = c >> 4, tk = (c & 15) * 8;
          int n = n0 + col - kend, hk = n >> 6, d = n & 63;
          const float* s = Cs + tk * 132 + col;
          uint4 o; o.x = pk2(s[0], s[132]); o.y = pk2(s[2 * 132], s[3 * 132]); o.z = pk2(s[4 * 132], s[5 * 132]); o.w = pk2(s[6 * 132], s[7 * 132]);
          *(uint4*)(base + ((size_t)(b * HKV + hk) * 64 + d) * len + s0 + tk) = o;
        }
      } else {
        const bool rope = isA && !isctx && n0 < kend;
        const float mul = (n0 < qend) ? 0.125f : 1.f;
        const bool gate = n0 >= vend;
        const int NW = isA ? 2560 : 4096;
#pragma unroll 1
        for (int i = 0; i < 8; ++i) {
          int c = tid + i * 256, row = c >> 4, cc = (c & 15) * 8;
          const float* s = Cs + row * 132 + cc;
          float v[8];
#pragma unroll
          for (int e = 0; e < 8; ++e) v[e] = s[e];
          if (rope) {
            int sp = (m0 + row) & 2047;
            int dd = (n0 + cc) & 63;
            int pos = (dd < 32) ? (sp >> 6) : (sp & 63);
            bool first = (dd & 31) < 16;
            int j0 = dd & 15;
            const float* pr = s + (first ? 16 : -16);
            const float* tb = p.rope + (pos * 16 + j0) * 2;
#pragma unroll
            for (int e = 0; e < 8; ++e) {
              float cs = tb[e * 2], sn = tb[e * 2 + 1];
              v[e] = first ? (v[e] * cs - pr[e] * sn) : (v[e] * cs + pr[e] * sn);
            }
          }
          if (gate) {
#pragma unroll
            for (int e = 0; e < 8; ++e) v[e] = silu_f(v[e]);
          } else {
#pragma unroll
            for (int e = 0; e < 8; ++e) v[e] *= mul;
          }
          uint4 o; o.x = pk2(v[0], v[1]); o.y = pk2(v[2], v[3]); o.z = pk2(v[4], v[5]); o.w = pk2(v[6], v[7]);
          *(uint4*)(p.qkvg + (size_t)(m0 + row) * NW + n0 + cc) = o;
        }
      }
    }
  }
  __syncthreads();
}

DI void attn_naive_phase(const Params& p, int layer, float* smem) {
  const bool isA = !(layer & 1);
  const bool ctx_out = layer < 3;
  const int jl = layer >> 1;
  const int NW = isA ? 2560 : 4096, HKV = isA ? 4 : 16, koff = 1024, goff = isA ? 1536 : 3072;
  const int tid = threadIdx.x, lane = tid & 63, wave = tid >> 6;
  float* red = smem + wave * (64 * 65);
  const int ntasks = (ctx_out ? TT : TL) * 16;
  for (int task = blockIdx.x * 4 + wave; task < ntasks; task += gridDim.x * 4) {
    const int t = task >> 4, hq = task & 15;
    const int hk = isA ? (hq >> 2) : hq;
    const bool isctx = t >= TL;
    const int b = isctx ? ((t - TL) >> 8) : (t >> 11);
    const int s = isctx ? ((t - TL) & 255) : (t & 2047);
    const bf16_t* qrow = p.qkvg + (size_t)t * NW + hq * 64;
    const int nlat = isctx ? 0 : (isA ? 257 : 128);
    const int nk = nlat + 256;
    const int rq = s >> 6, cq = s & 63;
    const int rs = clampi(rq - 4, 0, 24), cs = clampi(cq - 8, 0, 48);
    float pr[9];
    float mx = -1e30f;
#pragma unroll
    for (int k = 0; k < 9; ++k) {
      const int idx = lane + 64 * k;
      float sv = -1e30f;
      if (idx < nk) {
        int kt; float bias = 0.f; bool valid = true;
        if (idx < nlat) {
          if (isA) { int kj = s - 128 + idx; valid = (kj >= 0) && (kj < 2048); kt = b * 2048 + (valid ? kj : 0); }
          else {
            int rr = rs + (idx >> 4), kc = cs + (idx & 15);
            kt = b * 2048 + rr * 64 + kc;
            bias = p.b_rel_bias[(((size_t)jl * 16 + hq) * 15 + (rr - rq + 7)) * 31 + (kc - cq + 15)];
          }
        } else kt = TL + b * 256 + (idx - nlat);
        const bf16_t* krow = p.qkvg + (size_t)kt * NW + koff + hk * 64;
        float dot = 0.f;
        for (int d = 0; d < 64; d += 2) {
          unsigned qa = *(const unsigned*)(qrow + d), ka = *(const unsigned*)(krow + d);
          dot += bflo(qa) * bflo(ka) + bfhi(qa) * bfhi(ka);
        }
        sv = valid ? (dot + bias) : -1e30f;
      }
      pr[k] = sv;
      mx = fmaxf(mx, sv);
    }
    const bool has_sink = isA;
    const float sinkv = has_sink ? p.a_sink[jl * 16 + hq] : -1e30f;
    mx = fmaxf(wave_max(mx), sinkv);
    float sum = 0.f;
#pragma unroll
    for (int k = 0; k < 9; ++k) {
      const int idx = lane + 64 * k;
      float e = (idx < nk) ? __expf(pr[k] - mx) : 0.f;
      pr[k] = e; sum += e;
    }
    sum = wave_sum(sum) + (has_sink ? __expf(sinkv - mx) : 0.f);
    float o[64];
#pragma unroll
    for (int d = 0; d < 64; ++d) o[d] = 0.f;
    const bf16_t* vl = p.vt + ((size_t)(b * HKV + hk) * 64) * 2048;
    const bf16_t* vc = p.vtc + ((size_t)(b * HKV + hk) * 64) * 256;
#pragma unroll
    for (int k = 0; k < 9; ++k) {
      const int idx = lane + 64 * k;
      if (idx < nk) {
        const bf16_t* base; int stride;
        if (idx < nlat) {
          int kj;
          if (isA) kj = clampi(s - 128 + idx, 0, 2047);
          else kj = (rs + (idx >> 4)) * 64 + cs + (idx & 15);
          base = vl + kj; stride = 2048;
        } else { base = vc + (idx - nlat); stride = 256; }
        const float pk = pr[k];
#pragma unroll
        for (int d = 0; d < 64; ++d) o[d] += pk * bf2f(base[(size_t)d * stride]);
      }
    }
    __syncthreads();
#pragma unroll
    for (int d = 0; d < 64; ++d) red[lane * 65 + d] = o[d];
    __syncthreads();
    float od = 0.f;
    for (int l = 0; l < 64; ++l) od += red[l * 65 + lane];
    od /= sum;
    bf16_t* gp = p.qkvg + (size_t)t * NW + goff + hq * 64 + lane;
    float g = bf2f(*gp);
    *gp = (bf16_t)(pk2(od * g, 0.f) & 0xffffu);
  }
}

DI void ln_phase(const Params& p, int layer) {
  const int tid = threadIdx.x, lane = tid & 63, wave = tid >> 6;
  const int nrows = (layer < 3) ? TT : TL;
  const float* lg = p.ln_g + layer * 1024;
  const float* lb = p.ln_b + layer * 1024;
  for (int row = blockIdx.x * 4 + wave; row < nrows; row += gridDim.x * 4) {
    const bool isctx = row >= TL;
    const int b = isctx ? 32 : (row >> 11);
    const float* hin = isctx ? ((layer == 0 ? p.ctx : p.hc) + (size_t)(row - TL) * 1024) : ((layer == 0 ? p.x : p.out) + (size_t)row * 1024);
    float* hout = isctx ? (p.hc + (size_t)(row - TL) * 1024) : (p.out + (size_t)row * 1024);
    const float* md = p.mod + ((size_t)layer * 33 + b) * 3072;
    bf16_t* yu = p.u + (size_t)row * 1024;
    float z[16];
    float sum = 0.f;
#pragma unroll
    for (int i = 0; i < 4; ++i) {
      int col = i * 256 + lane * 4;
      float4 hv = *(const float4*)(hin + col);
      float4 gv = *(const float4*)(md + 2048 + col);
      uint2 yv = *(const uint2*)(yu + col);
      z[i * 4 + 0] = ALPHA * hv.x + gv.x * bflo(yv.x);
      z[i * 4 + 1] = ALPHA * hv.y + gv.y * bfhi(yv.x);
      z[i * 4 + 2] = ALPHA * hv.z + gv.z * bflo(yv.y);
      z[i * 4 + 3] = ALPHA * hv.w + gv.w * bfhi(yv.y);
      sum += z[i * 4 + 0] + z[i * 4 + 1] + z[i * 4 + 2] + z[i * 4 + 3];
    }
    const float mean = wave_sum(sum) * (1.f / 1024.f);
    float sq = 0.f;
#pragma unroll
    for (int e = 0; e < 16; ++e) { float d = z[e] - mean; sq += d * d; }
    const float rstd = rsqrtf(wave_sum(sq) * (1.f / 1024.f) + 1e-5f);
    const float* md2 = p.mod + ((size_t)(layer + 1) * 33 + b) * 3072;
#pragma unroll
    for (int i = 0; i < 4; ++i) {
      int col = i * 256 + lane * 4;
      float4 g4 = *(const float4*)(lg + col), b4 = *(const float4*)(lb + col);
      float4 o;
      o.x = (z[i * 4 + 0] - mean) * rstd * g4.x + b4.x;
      o.y = (z[i * 4 + 1] - mean) * rstd * g4.y + b4.y;
      o.z = (z[i * 4 + 2] - mean) * rstd * g4.z + b4.z;
      o.w = (z[i * 4 + 3] - mean) * rstd * g4.w + b4.w;
      *(float4*)(hout + col) = o;
      if (layer < 3) {
        float4 sh = *(const float4*)(md2 + col), sc = *(const float4*)(md2 + 1024 + col);
        uint2 uo;
        uo.x = pk2(o.x * (1.f + sc.x) + sh.x, o.y * (1.f + sc.y) + sh.y);
        uo.y = pk2(o.z * (1.f + sc.z) + sh.z, o.w * (1.f + sc.w) + sh.w);
        *(uint2*)(yu + col) = uo;
      }
    }
  }
}

__global__ void __launch_bounds__(256, 1) mega(Params p, int ph_lo, int ph_hi) {
  __shared__ __attribute__((aligned(16))) char smem[SMEM_BYTES];
  for (int ph = ph_lo; ph < ph_hi; ++ph) {
    if (ph == 0) phase_prep(p, (float*)smem);
    else if (ph == 1) phase_mod0(p);
    else {
      const int layer = (ph - 2) >> 2, sub = (ph - 2) & 3;
      const bool isA = !(layer & 1);
      const int jl = layer >> 1;
      const int NW = isA ? 2560 : 4096;
      if (sub == 0) {
        const int M = (layer < 3) ? TT : TT;
        if (isA) gemm_phase<EPI_A>(p, p.u, 1024, p.wt_a_in + (size_t)jl * 2560 * 1024, M, 2560, smem);
        else gemm_phase<EPI_B>(p, p.u, 1024, p.wt_b_in + (size_t)jl * 4096 * 1024, M, 4096, smem);
      } else if (sub == 1) {
        attn_naive_phase(p, layer, (float*)smem);
      } else if (sub == 2) {
        const int M = (layer < 3) ? TT : TL;
        const int goff = isA ? 1536 : 3072;
        gemm_phase<EPI_OUT>(p, p.qkvg + goff, NW, (isA ? p.wt_a_out : p.wt_b_out) + (size_t)jl * 1024 * 1024, M, 1024, smem);
      } else {
        ln_phase(p, layer);
      }
    }
    if (ph + 1 < ph_hi) cg::this_grid().sync();
  }
}

extern "C" void kernel_launch(void* const* d_in, const int* in_sizes, int n_in, void* d_out, int out_size, void* d_ws, size_t ws_size,
                              hipStream_t stream) {
  static int grid_blocks = 0;
  if (!grid_blocks) {
    int dev = 0, cus = 0, per_cu = 0;
    hipGetDevice(&dev);
    hipDeviceGetAttribute(&cus, hipDeviceAttributeMultiprocessorCount, dev);
    hipOccupancyMaxActiveBlocksPerMultiprocessor(&per_cu, mega, 256, 0);
    if (per_cu < 1) per_cu = 1;
    grid_blocks = cus * per_cu;
  }
  Params p{};
  p.x = (const float*)d_in[0]; p.c = (const float*)d_in[1]; p.ctx = (const float*)d_in[2]; p.c_ctx = (const float*)d_in[3];
  p.w_ada = (const float*)d_in[4]; p.b_ada = (const float*)d_in[5]; p.ln_g = (const float*)d_in[6]; p.ln_b = (const float*)d_in[7];
  p.a_w_in = (const float*)d_in[8]; p.a_w_out = (const float*)d_in[9]; p.a_sink = (const float*)d_in[10];
  p.b_w_in = (const float*)d_in[11]; p.b_w_out = (const float*)d_in[12]; p.b_rel_bias = (const float*)d_in[13];
  p.out = (float*)d_out;
  char* w = (char*)d_ws;
  size_t off = 0;
  auto take = [&](size_t bytes) { char* r = w + off; off += (bytes + 255) & ~(size_t)255; return r; };
  p.hc = (float*)take((size_t)TC * 1024 * 4);
  p.u = (bf16_t*)take((size_t)TT * 1024 * 2);
  p.qkvg = (bf16_t*)take((size_t)TT * 4096 * 2);
  p.vt = (bf16_t*)take((size_t)NB * 16 * 64 * 2048 * 2);
  p.vtc = (bf16_t*)take((size_t)NB * 16 * 64 * 256 * 2);
  p.wt_a_in = (bf16_t*)take((size_t)2 * 2560 * 1024 * 2);
  p.wt_a_out = (bf16_t*)take((size_t)2 * 1024 * 1024 * 2);
  p.wt_b_in = (bf16_t*)take((size_t)2 * 4096 * 1024 * 2);
  p.wt_b_out = (bf16_t*)take((size_t)2 * 1024 * 1024 * 2);
  p.mod = (float*)take((size_t)5 * 33 * 3072 * 4);
  p.rope = (float*)take((size_t)64 * 16 * 2 * 4);
  if (off > ws_size) { fprintf(stderr, "workspace too small: need %zu have %zu\n", off, ws_size); return; }
#if MK_COOP
  int lo = 0, hi = NPHASE;
  void* args[] = {&p, &lo, &hi};
  hipError_t e = hipLaunchCooperativeKernel((void*)mega, dim3(grid_blocks), dim3(256), args, 0, stream);
  if (e != hipSuccess) fprintf(stderr, "cooperative launch failed: %s (grid %d)\n", hipGetErrorString(e), grid_blocks);
#else
  for (int ph = 0; ph < NPHASE; ++ph) hipLaunchKernelGGL(mega, dim3(grid_blocks), dim3(256), 0, stream, p, ph, ph + 1);
#endif
}
```

```cpp
#include <hip/hip_runtime.h>
#include <hip/hip_cooperative_groups.h>
#include <cstdio>
namespace cg = cooperative_groups;

#ifndef MK_COOP
#define MK_COOP 1
#endif

typedef unsigned short bf16_t;
typedef short bf16x8 __attribute__((ext_vector_type(8)));
typedef float f32x16 __attribute__((ext_vector_type(16)));
typedef float f32x2 __attribute__((ext_vector_type(2)));
typedef __bf16 bf16x2v __attribute__((ext_vector_type(2)));
typedef float f32x4 __attribute__((ext_vector_type(4)));
typedef unsigned u32x4 __attribute__((ext_vector_type(4)));
typedef unsigned u32x2 __attribute__((ext_vector_type(2)));

#define DI __device__ __forceinline__
#define LAS3 __attribute__((address_space(3)))

constexpr int NB = 32, SEQ = 2048, DM = 1024, CTXL = 256;
constexpr int TL = NB * SEQ;
constexpr int TC = NB * CTXL;
constexpr int TT = TL + TC;
constexpr int NPHASE = 18;
constexpr float ALPHA = 1.681792830507429f;
constexpr int SMEM_BYTES = 98304 + 32768 + 8704 + 16;
constexpr int SMEM_BAR = 98304 + 32768 + 8704;
constexpr int NTHR = 512;

DI unsigned pk2(float lo, float hi) { f32x2 v = {lo, hi}; return __builtin_bit_cast(unsigned, __builtin_convertvector(v, bf16x2v)); }
DI float bf2f(bf16_t x) { return __uint_as_float(((unsigned)x) << 16); }
DI float bflo(unsigned u) { return __uint_as_float(u << 16); }
DI float bfhi(unsigned u) { return __uint_as_float(u & 0xffff0000u); }
DI float silu_f(float x) { return x * __builtin_amdgcn_rcpf(1.f + __expf(-x)); }
DI float wave_sum(float v) {
#pragma unroll
  for (int o = 32; o > 0; o >>= 1) v += __shfl_xor(v, o);
  return v;
}
DI float wave_max(float v) {
#pragma unroll
  for (int o = 32; o > 0; o >>= 1) v = fmaxf(v, __shfl_xor(v, o));
  return v;
}
DI int opaque_tid() { int t = threadIdx.x; asm volatile("" : "+v"(t)); return t; }
DI int clampi(int x, int lo, int hi) { return x < lo ? lo : (x > hi ? hi : x); }

struct Params {
  const float *x, *c, *ctx, *c_ctx, *w_ada, *b_ada, *ln_g, *ln_b, *a_w_in, *a_w_out, *a_sink, *b_w_in, *b_w_out, *b_rel_bias;
  float* out;
  float* hc;
  bf16_t* u;
  bf16_t* qkvg;
  unsigned short* h16;
  bf16_t* wt_a_in;
  bf16_t* wt_a_out;
  bf16_t* wt_b_in;
  bf16_t* wt_b_out;
  float* mod;
  float* rope;
  unsigned* bar;
};

DI void prep_mod_item(const Params& p, int item, float* smem) {
  const int tid = opaque_tid(), lane = tid & 63, wv = tid >> 6;
  const int layer = item / 48, cgp = item % 48;
  const int col = cgp * 64 + lane;
  float acc[33];
#pragma unroll
  for (int b = 0; b < 33; ++b) acc[b] = 0.f;
  const float* W = p.w_ada + (size_t)layer * 1024 * 3072;
#pragma unroll 1
  for (int half = 0; half < 2; ++half) {
    __syncthreads();
    for (int e = tid; e < 33 * 512; e += NTHR) {
      const int kk = e & 511, b = e >> 9;
      const int k = half * 512 + kk;
      const float v = (b < 32) ? p.c[b * 1024 + k] : p.c_ctx[k];
      smem[e] = silu_f(v);
    }
    __syncthreads();
    const float* Wh = W + (size_t)(half * 512 + wv * 64) * 3072 + col;
    const float* sg = smem + wv * 64;
#pragma unroll 16
    for (int kk = 0; kk < 64; ++kk) {
      const float w = Wh[(size_t)kk * 3072];
#pragma unroll
      for (int b = 0; b < 33; ++b) acc[b] += sg[b * 512 + kk] * w;
    }
  }
  __syncthreads();
#pragma unroll
  for (int b = 0; b < 33; ++b) smem[(wv * 33 + b) * 64 + lane] = acc[b];
  __syncthreads();
  for (int e = tid; e < 33 * 64; e += NTHR) {
    const int l = e & 63, b = e >> 6;
    float s = 0.f;
#pragma unroll
    for (int w = 0; w < 8; ++w) s += smem[(w * 33 + b) * 64 + l];
    const int cc = cgp * 64 + l;
    p.mod[((size_t)layer * 33 + b) * 3072 + cc] = s + p.b_ada[layer * 3072 + cc];
  }
  __syncthreads();
}

DI void prep_transpose_item(const float* W, bf16_t* Wt, int N, int kt, int ng, float* smem) {
  const int tid = opaque_tid();
  __syncthreads();
#pragma unroll
  for (int t = 0; t < 4; ++t)
#pragma unroll
    for (int i = 0; i < 8; ++i) {
      const int kl = i * 8 + (tid >> 6), nl = tid & 63;
      smem[t * (64 * 65) + kl * 65 + nl] = W[(size_t)(kt * 64 + kl) * N + ng * 256 + t * 64 + nl];
    }
  __syncthreads();
#pragma unroll
  for (int t = 0; t < 4; ++t)
#pragma unroll
    for (int i = 0; i < 8; ++i) {
      const int nl = i * 8 + (tid >> 6), kl = tid & 63;
      const float v = smem[t * (64 * 65) + kl * 65 + nl];
      Wt[(size_t)(ng * 256 + t * 64 + nl) * 1024 + kt * 64 + kl] = (bf16_t)(pk2(v, 0.f) & 0xffffu);
    }
}

DI void phase_prep(const Params& p, float* smem) {
  const int n_ain = 2 * 16 * 10, n_aout = 2 * 16 * 4, n_bin = 2 * 16 * 16, n_bout = 2 * 16 * 4;
  const int total = n_ain + n_aout + n_bin + n_bout + 192 + 1;
  for (int item = blockIdx.x; item < total; item += gridDim.x) {
    int it = item;
    if (it < n_ain) { int l = it / 160, r = it % 160; prep_transpose_item(p.a_w_in + (size_t)l * 1024 * 2560, p.wt_a_in + (size_t)l * 2560 * 1024, 2560, r / 10, r % 10, smem); continue; }
    it -= n_ain;
    if (it < n_aout) { int l = it / 64, r = it % 64; prep_transpose_item(p.a_w_out + (size_t)l * 1024 * 1024, p.wt_a_out + (size_t)l * 1024 * 1024, 1024, r / 4, r % 4, smem); continue; }
    it -= n_aout;
    if (it < n_bin) { int l = it / 256, r = it % 256; prep_transpose_item(p.b_w_in + (size_t)l * 1024 * 4096, p.wt_b_in + (size_t)l * 4096 * 1024, 4096, r / 16, r % 16, smem); continue; }
    it -= n_bin;
    if (it < n_bout) { int l = it / 64, r = it % 64; prep_transpose_item(p.b_w_out + (size_t)l * 1024 * 1024, p.wt_b_out + (size_t)l * 1024 * 1024, 1024, r / 4, r % 4, smem); continue; }
    it -= n_bout;
    if (it < 192) { prep_mod_item(p, it, smem); continue; }
    for (int e = opaque_tid(); e < 64 * 16; e += NTHR) {
      int pos = e >> 4, j = e & 15;
      float inv = powf(10000.0f, -(float)j / 16.0f);
      float ang = (float)pos * inv;
      p.rope[e * 2 + 0] = cosf(ang);
      p.rope[e * 2 + 1] = sinf(ang);
    }
  }
}

DI void mod0_row(const float* src, bf16_t* dst, int c0, const float4 sc0, const float4 sc1, const float4 sc2, const float4 sc3,
                 const float4 sh0, const float4 sh1, const float4 sh2, const float4 sh3) {
  const f32x4 v0 = __builtin_nontemporal_load((const f32x4*)(src + c0)), v1 = __builtin_nontemporal_load((const f32x4*)(src + c0 + 256));
  const f32x4 v2 = __builtin_nontemporal_load((const f32x4*)(src + c0 + 512)), v3 = __builtin_nontemporal_load((const f32x4*)(src + c0 + 768));
  uint2 o;
  o.x = pk2(v0[0] * (1.f + sc0.x) + sh0.x, v0[1] * (1.f + sc0.y) + sh0.y); o.y = pk2(v0[2] * (1.f + sc0.z) + sh0.z, v0[3] * (1.f + sc0.w) + sh0.w);
  *(uint2*)(dst + c0) = o;
  o.x = pk2(v1[0] * (1.f + sc1.x) + sh1.x, v1[1] * (1.f + sc1.y) + sh1.y); o.y = pk2(v1[2] * (1.f + sc1.z) + sh1.z, v1[3] * (1.f + sc1.w) + sh1.w);
  *(uint2*)(dst + c0 + 256) = o;
  o.x = pk2(v2[0] * (1.f + sc2.x) + sh2.x, v2[1] * (1.f + sc2.y) + sh2.y); o.y = pk2(v2[2] * (1.f + sc2.z) + sh2.z, v2[3] * (1.f + sc2.w) + sh2.w);
  *(uint2*)(dst + c0 + 512) = o;
  o.x = pk2(v3[0] * (1.f + sc3.x) + sh3.x, v3[1] * (1.f + sc3.y) + sh3.y); o.y = pk2(v3[2] * (1.f + sc3.z) + sh3.z, v3[3] * (1.f + sc3.w) + sh3.w);
  *(uint2*)(dst + c0 + 768) = o;
}
DI void phase_mod0(const Params& p) {
  const int tid = opaque_tid(), lane = tid & 63, wave = __builtin_amdgcn_readfirstlane(tid >> 6);
  const int c0 = lane * 4;
  const int nw = gridDim.x * 8, gw = blockIdx.x * 8 + wave;
  const int r_lo = (int)(((long)gw * TT) / nw), r_hi = (int)(((long)(gw + 1) * TT) / nw);
  int bcur = -1;
  float4 sc0, sc1, sc2, sc3, sh0, sh1, sh2, sh3;
  sc0 = sc1 = sc2 = sc3 = sh0 = sh1 = sh2 = sh3 = make_float4(0.f, 0.f, 0.f, 0.f);
#pragma unroll 1
  for (int row = r_lo; row < r_hi; ++row) {
    const bool isctx = row >= TL;
    const int b = isctx ? 32 : (row >> 11);
    if (b != bcur) {
      bcur = b;
      const float* md = p.mod + (size_t)b * 3072;
      sh0 = *(const float4*)(md + c0); sh1 = *(const float4*)(md + c0 + 256); sh2 = *(const float4*)(md + c0 + 512); sh3 = *(const float4*)(md + c0 + 768);
      sc0 = *(const float4*)(md + 1024 + c0); sc1 = *(const float4*)(md + 1024 + c0 + 256); sc2 = *(const float4*)(md + 1024 + c0 + 512); sc3 = *(const float4*)(md + 1024 + c0 + 768);
    }
    const float* srcp = isctx ? (p.ctx + (size_t)(row - TL) * 1024) : (p.x + (size_t)row * 1024);
    mod0_row(srcp, p.u + (size_t)row * 1024, c0, sc0, sc1, sc2, sc3, sh0, sh1, sh2, sh3);
  }
}

namespace pg8 {
#define PG8_LAS __attribute__((address_space(3)))
constexpr int BM = 256, BK = 64, HALF = 128, HTB = HALF * BK * 2, STAGE_BYTES = 8 * HTB, NXCD = 8, WGM = 8;
DI int lds_byte(int r, int c) { const int st = (r >> 4) * 2 + (c >> 5), rr = r & 15, cc = c & 31, ob = rr * 64 + cc * 2; return st * 1024 + (ob ^ (((ob >> 9) & 1) << 5)); }
DI void stage_rc(int b, int& R, int& C) { const int st = b / 1024, sb = b % 1024, swz = sb ^ (((sb >> 9) & 1) << 5); R = (st >> 1) * 16 + swz / 64; C = (st & 1) * 32 + (swz % 64) / 2; }
DI int perm32(int rho) { const int n = rho >> 4, i = rho & 15; return 8 * (i >> 2) + 4 * n + (i & 3); }
struct Unit { int pm, pn; };
struct Gemm { const bf16_t* A; const bf16_t* Bt; int M, N, K, lda; };
struct StaticOrder {
  int nM, nN, nwg, G, c;
  DI void init(int M, int N, int G_, int c_) { nM = M / BM; nN = N / BM; nwg = nM * nN; G = G_; c = c_; }
  DI bool next(int i, Unit& u) const {
    const long L = (long)i * G + c; if (L >= nwg) return false;
    int wgid = (int)L; { const int q = nwg / NXCD, r = nwg % NXCD, xcd = wgid % NXCD, off = wgid / NXCD; wgid = (xcd < r ? xcd * (q + 1) : r * (q + 1) + (xcd - r) * q) + off; }
    const int nig = WGM * nN, gid = wgid / nig, fm = gid * WGM, gsz = (nM - fm) < WGM ? (nM - fm) : WGM;
    u.pm = fm + ((wgid % nig) % gsz); u.pn = (wgid % nig) / gsz; return true;
  }
};

template <class Epi>
DI void gemm_phase(PG8_LAS unsigned char* lds, const Gemm g, const StaticOrder& S, const Epi& E) {
  const int tid = opaque_tid(), wid = __builtin_amdgcn_readfirstlane(tid >> 6), lane = tid & 63, wr = wid >> 2, wc = wid & 3, fr = lane & 15, fq = lane >> 4;
  const int K = g.K, nt = K / BK, lda = g.lda;
  unsigned voffA[2], voffB[2];
#pragma unroll
  for (int i = 0; i < 2; ++i) { int R, C; stage_rc(tid * 16 + i * 8192, R, C); const int Rb = Epi::PERM ? ((R & ~31) + perm32(R & 31)) : R;
    voffA[i] = (unsigned)(R * lda + C) * 2u; voffB[i] = (unsigned)(Rb * K + C) * 2u; }
  const size_t kstep = (size_t)(BK * 2);
  const size_t hstepA = (size_t)HALF * lda * 2, hstepB = (size_t)HALF * K * 2;
  const size_t tstepA = 2 * hstepA, tstepB = 2 * hstepB;
  const unsigned ldsw = (unsigned)wid * 1024u;
  const int aoff = lds_byte(wr * 64 + fr, fq * 8), boff = lds_byte(wc * 32 + fr, fq * 8);
#define PG8_SA(b, h) (((b) * 2 + (h)) * HTB)
#define PG8_SB(b, h) ((4 + (b) * 2 + (h)) * HTB)
#define PG8_STAGE(bufoff, gbase, voff) do { _Pragma("unroll") for (int _i = 0; _i < 2; ++_i) \
    __builtin_amdgcn_global_load_lds((const unsigned*)((const char*)(gbase) + (voff)[_i]), (PG8_LAS unsigned*)(lds + (bufoff) + ldsw + _i * 8192), 16, 0, 0); } while (0)
#define PG8_LDA(dst, b, h) do { _Pragma("unroll") for (int m = 0; m < 4; ++m) _Pragma("unroll") for (int k = 0; k < 2; ++k) dst[m][k] = *(const PG8_LAS bf16x8*)(lds + PG8_SA(b, h) + aoff + m * 2048 + k * 1024); } while (0)
#define PG8_LDB(dst, b, h) do { _Pragma("unroll") for (int n = 0; n < 2; ++n) _Pragma("unroll") for (int k = 0; k < 2; ++k) dst[n][k] = *(const PG8_LAS bf16x8*)(lds + PG8_SB(b, h) + boff + n * 2048 + k * 1024); } while (0)
#define PG8_MMA(ai, bj, At, Bt) do { __builtin_amdgcn_s_setprio(1); _Pragma("unroll") for (int m = 0; m < 4; ++m) _Pragma("unroll") for (int n = 0; n < 2; ++n) _Pragma("unroll") for (int k = 0; k < 2; ++k) \
    acc[ai][bj][m][n] = __builtin_amdgcn_mfma_f32_16x16x32_bf16(Bt[n][k], At[m][k], acc[ai][bj][m][n], 0, 0, 0); __builtin_amdgcn_s_setprio(0); } while (0)
#define PG8_WAIT_V(n) asm volatile("s_waitcnt vmcnt(" #n ")" ::: "memory")
#define PG8_WAIT_L(n) asm volatile("s_waitcnt lgkmcnt(" #n ")" ::: "memory")
#define PG8_BAR __builtin_amdgcn_s_barrier()
#define PG8_SCHED __builtin_amdgcn_sched_barrier(0)
  Unit cur, nxt; int ui = 0;
  if (!S.next(0, cur)) return;
  f32x4 acc[2][2][4][2];
#pragma unroll
  for (int a = 0; a < 2; ++a)
#pragma unroll
    for (int b = 0; b < 2; ++b)
#pragma unroll
      for (int m = 0; m < 4; ++m)
#pragma unroll
        for (int n = 0; n < 2; ++n) acc[a][b][m][n] = (f32x4){0.f, 0.f, 0.f, 0.f};
  bf16x8 At[4][2], B0[2][2], B1[2][2];
  const char* cA = (const char*)g.A + (size_t)cur.pm * tstepA; const char* cB = (const char*)g.Bt + (size_t)cur.pn * tstepB;
  PG8_STAGE(PG8_SB(0, 0), cB, voffB); PG8_STAGE(PG8_SA(0, 0), cA, voffA); PG8_STAGE(PG8_SB(0, 1), cB + hstepB, voffB); PG8_STAGE(PG8_SA(0, 1), cA + hstepA, voffA);
  if (wr == 1) PG8_BAR;
  PG8_WAIT_V(4); PG8_BAR;
  PG8_STAGE(PG8_SB(1, 0), cB + kstep, voffB); PG8_STAGE(PG8_SA(1, 0), cA + kstep, voffA); PG8_STAGE(PG8_SB(1, 1), cB + hstepB + kstep, voffB);
  PG8_WAIT_V(6); PG8_BAR;
  for (;;) {
    const bool has_next = S.next(ui + 1, nxt);
    const char* nA = has_next ? (const char*)g.A + (size_t)nxt.pm * tstepA : cA; const char* nB = has_next ? (const char*)g.Bt + (size_t)nxt.pn * tstepB : cB;
    for (int t = 0; t < nt; t += 2) {
      const bool last = (t == nt - 2);
      const char* a1 = cA + (size_t)(t + 1) * kstep;
      const char* a2 = last ? nA : cA + (size_t)(t + 2) * kstep; const char* b2 = last ? nB : cB + (size_t)(t + 2) * kstep;
      const char* a3 = a2 + kstep; const char* b3 = b2 + kstep;
      PG8_LDB(B0, 0, 0); PG8_SCHED; PG8_LDA(At, 0, 0); PG8_STAGE(PG8_SA(1, 1), a1 + hstepA, voffA);
      PG8_WAIT_L(8); PG8_BAR; PG8_WAIT_L(0); PG8_MMA(0, 0, At, B0); PG8_BAR; PG8_SCHED;
      PG8_LDB(B1, 0, 1); PG8_STAGE(PG8_SB(0, 0), b2, voffB);
      PG8_BAR; PG8_WAIT_L(0); PG8_MMA(0, 1, At, B1); PG8_BAR;
      PG8_LDA(At, 0, 1); PG8_STAGE(PG8_SA(0, 0), a2, voffA);
      PG8_BAR; PG8_WAIT_L(0); PG8_MMA(1, 0, At, B0); PG8_BAR; PG8_SCHED;
      PG8_STAGE(PG8_SB(0, 1), b2 + hstepB, voffB);
      PG8_WAIT_V(6); PG8_BAR; PG8_MMA(1, 1, At, B1); PG8_BAR;
      PG8_LDB(B0, 1, 0); PG8_SCHED; PG8_LDA(At, 1, 0); PG8_STAGE(PG8_SA(0, 1), a2 + hstepA, voffA);
      PG8_WAIT_L(8); PG8_BAR; PG8_WAIT_L(0); PG8_MMA(0, 0, At, B0); PG8_BAR; PG8_SCHED;
      PG8_LDB(B1, 1, 1); PG8_STAGE(PG8_SB(1, 0), b3, voffB);
      PG8_BAR; PG8_WAIT_L(0); PG8_MMA(0, 1, At, B1); PG8_BAR;
      PG8_LDA(At, 1, 1); PG8_STAGE(PG8_SA(1, 0), a3, voffA);
      PG8_BAR; PG8_WAIT_L(0); PG8_MMA(1, 0, At, B0); PG8_BAR; PG8_SCHED;
      PG8_STAGE(PG8_SB(1, 1), b3 + hstepB, voffB);
      PG8_WAIT_V(6); PG8_BAR; PG8_MMA(1, 1, At, B1); PG8_BAR;
    }
    E(acc, cur, wr, wc, fr, fq);
    if (!has_next) break;
#pragma unroll
    for (int a = 0; a < 2; ++a)
#pragma unroll
      for (int b = 0; b < 2; ++b)
#pragma unroll
        for (int m = 0; m < 4; ++m)
#pragma unroll
          for (int n = 0; n < 2; ++n) acc[a][b][m][n] = (f32x4){0.f, 0.f, 0.f, 0.f};
    cur = nxt; cA = nA; cB = nB; ++ui;
  }
  PG8_WAIT_V(0);
  if (wr == 0) PG8_BAR;
  PG8_BAR;
#undef PG8_SA
#undef PG8_SB
#undef PG8_STAGE
#undef PG8_LDA
#undef PG8_LDB
#undef PG8_MMA
#undef PG8_WAIT_V
#undef PG8_WAIT_L
#undef PG8_BAR
#undef PG8_SCHED
}
}

template <int MODE>
struct EpiMk {
  static constexpr bool PERM = true;
  bf16_t* u; bf16_t* qkvg; LAS3 const float* rope;
  int pm_off, pn_off;
  DI void operator()(const f32x4 (&acc)[2][2][4][2], const pg8::Unit& un, int wr, int wc, int fr, int fq) const {
    constexpr bool isA = (MODE == 0);
    constexpr int NW = isA ? 2560 : 4096, kend = isA ? 1280 : 2048, vend = isA ? 1536 : 3072;
    const int upm = un.pm + pm_off, upn = un.pn + pn_off;
    const bool isctx = upm >= 256;
#pragma unroll
    for (int ai = 0; ai < 2; ++ai)
#pragma unroll
      for (int m = 0; m < 4; ++m) {
        const int row = upm * 256 + ai * 128 + wr * 64 + m * 16 + fr;
#pragma unroll
        for (int bj = 0; bj < 2; ++bj) {
          const int c128 = upn * 256 + bj * 128;
          const int col0 = c128 + wc * 32 + fq * 8;
          f32x4 v0 = acc[ai][bj][m][0], v1 = acc[ai][bj][m][1];
          if (MODE == 2) {
            u32x4 w; w[0] = pk2(v0[0], v0[1]); w[1] = pk2(v0[2], v0[3]); w[2] = pk2(v1[0], v1[1]); w[3] = pk2(v1[2], v1[3]);
            *(u32x4*)(u + (size_t)row * 1024 + col0) = w;
          } else {
            if (isA && !isctx && c128 < kend) {
              f32x4 p0, p1;
#pragma unroll
              for (int e = 0; e < 4; ++e) { p0[e] = __shfl_xor(v0[e], 32); p1[e] = __shfl_xor(v1[e], 32); }
              const int sp = row & 2047;
              const int pos = (wc & 1) ? (sp & 63) : (sp >> 6);
              LAS3 const float* tb = rope + (pos * 16 + 8 * (fq & 1)) * 2;
              const f32x4 t0 = *(LAS3 const f32x4*)(tb), t1 = *(LAS3 const f32x4*)(tb + 4), t2 = *(LAS3 const f32x4*)(tb + 8), t3 = *(LAS3 const f32x4*)(tb + 12);
              const float sg = (fq < 2) ? -1.f : 1.f;
              v0[0] = v0[0] * t0[0] + sg * p0[0] * t0[1]; v0[1] = v0[1] * t0[2] + sg * p0[1] * t0[3];
              v0[2] = v0[2] * t1[0] + sg * p0[2] * t1[1]; v0[3] = v0[3] * t1[2] + sg * p0[3] * t1[3];
              v1[0] = v1[0] * t2[0] + sg * p1[0] * t2[1]; v1[1] = v1[1] * t2[2] + sg * p1[1] * t2[3];
              v1[2] = v1[2] * t3[0] + sg * p1[2] * t3[1]; v1[3] = v1[3] * t3[2] + sg * p1[3] * t3[3];
            }
            if (c128 >= vend) {
#pragma unroll
              for (int e = 0; e < 4; ++e) { v0[e] = silu_f(v0[e]); v1[e] = silu_f(v1[e]); }
            } else if (c128 < 1024) {
              v0 = v0 * (0.125f * 1.4426950408889634f); v1 = v1 * (0.125f * 1.4426950408889634f);
            }
            u32x4 w; w[0] = pk2(v0[0], v0[1]); w[1] = pk2(v0[2], v0[3]); w[2] = pk2(v1[0], v1[1]); w[3] = pk2(v1[2], v1[3]);
            *(u32x4*)(qkvg + (size_t)row * NW + col0) = w;
          }
        }
      }
  }
};

template <int MODE>
DI void gemm_phase(const Params& p, const bf16_t* A, int lda, const bf16_t* Wt, int M, int N, char* smem, int pm_off = 0, int pn_off = 0) {
  pg8::Gemm g; g.A = A; g.Bt = Wt; g.M = M; g.N = N; g.K = 1024; g.lda = lda;
  pg8::StaticOrder S; S.init(M, N, (int)gridDim.x, (int)blockIdx.x);
  LAS3 float* ropel = (LAS3 float*)((LAS3 char*)smem + 131072);
  if (MODE == 0) {
    const int tid = opaque_tid();
    for (int e = tid; e < 64 * 16 * 2; e += NTHR) ropel[e] = p.rope[e];
    __syncthreads();
  }
  EpiMk<MODE> E{p.u, p.qkvg, ropel, pm_off, pn_off};
  pg8::gemm_phase(( PG8_LAS unsigned char*)smem, g, S, E);
  __syncthreads();
}
enum { EPI_A = 0, EPI_B = 1, EPI_OUT = 2 };

typedef short s16x4 __attribute__((ext_vector_type(4)));
constexpr int ATT_STAGE = 32768, ATT_NST = 3;
constexpr int ATT_GATE = ATT_NST * ATT_STAGE;
constexpr int ATT_TAB = ATT_GATE + 32768;
constexpr int TAB_NH = 4, TAB_HEAD0 = 32, TAB_HSTR = 480, TAB_NEG = 32 + TAB_NH * 480 + 64, TAB_FLOATS = TAB_NEG + 128;
constexpr float LOG2E = 1.4426950408889634f;
DI int crow(int v, int h) { return (v & 3) + 8 * (v >> 2) + 4 * h; }
DI int swz(int row) { return (((row >> 1) & 1) << 2) | ((row >> 2) & 3); }
DI bf16x8 tr_pair(LAS3 const char* plo, LAS3 const char* phi) {
  const s16x4 lo = __builtin_amdgcn_ds_read_tr16_b64_v4i16((LAS3 s16x4*)(plo));
  const s16x4 hi = __builtin_amdgcn_ds_read_tr16_b64_v4i16((LAS3 s16x4*)(phi));
  return __builtin_shufflevector(lo, hi, 0, 1, 2, 3, 4, 5, 6, 7);
}
struct AttnLane { int kr0, kr1, kr2, kr3, vr00, vr01, vr10, vr11; };
DI f32x16 qk_tile(LAS3 const char* kb, const AttnLane& L, const bf16x8& q0, const bf16x8& q1, const bf16x8& q2, const bf16x8& q3, const f32x16& init) {
  f32x16 s = __builtin_amdgcn_mfma_f32_32x32x16_bf16(*(LAS3 const bf16x8*)(kb + L.kr0), q0, init, 0, 0, 0);
  s = __builtin_amdgcn_mfma_f32_32x32x16_bf16(*(LAS3 const bf16x8*)(kb + L.kr1), q1, s, 0, 0, 0);
  s = __builtin_amdgcn_mfma_f32_32x32x16_bf16(*(LAS3 const bf16x8*)(kb + L.kr2), q2, s, 0, 0, 0);
  s = __builtin_amdgcn_mfma_f32_32x32x16_bf16(*(LAS3 const bf16x8*)(kb + L.kr3), q3, s, 0, 0, 0);
  return s;
}
DI void pv_tile(LAS3 const char* vb, const AttnLane& L, const f32x16& pr, f32x16& o0, f32x16& o1) {
  u32x4 w0, w1;
  w0[0] = pk2(pr[0], pr[1]); w0[1] = pk2(pr[2], pr[3]); w0[2] = pk2(pr[4], pr[5]); w0[3] = pk2(pr[6], pr[7]);
  w1[0] = pk2(pr[8], pr[9]); w1[1] = pk2(pr[10], pr[11]); w1[2] = pk2(pr[12], pr[13]); w1[3] = pk2(pr[14], pr[15]);
  const bf16x8 pf0 = __builtin_bit_cast(bf16x8, w0), pf1 = __builtin_bit_cast(bf16x8, w1);
  o0 = __builtin_amdgcn_mfma_f32_32x32x16_bf16(tr_pair(vb + L.vr00, vb + L.vr01), pf0, o0, 0, 0, 0);
  o1 = __builtin_amdgcn_mfma_f32_32x32x16_bf16(tr_pair(vb + L.vr10, vb + L.vr11), pf0, o1, 0, 0, 0);
  o0 = __builtin_amdgcn_mfma_f32_32x32x16_bf16(tr_pair(vb + 2048 + L.vr00, vb + 2048 + L.vr01), pf1, o0, 0, 0, 0);
  o1 = __builtin_amdgcn_mfma_f32_32x32x16_bf16(tr_pair(vb + 2048 + L.vr10, vb + 2048 + L.vr11), pf1, o1, 0, 0, 0);
}

struct AttnSt { f32x16 o0, o1, cinit; float m, l; };

template <int MK>
DI void attn_chunk(LAS3 const char* k0, LAS3 const char* k1, LAS3 const char* v0, LAS3 const char* v1, const AttnLane& L,
                   const bf16x8& q0, const bf16x8& q1, const bf16x8& q2, const bf16x8& q3,
                   AttnSt& st, const f32x16& init, const int h, const int kb0, const int kb1, const int sq, LAS3 const float* b0, LAS3 const float* b1) {
  f32x16 s0 = qk_tile(k0, L, q0, q1, q2, q3, init);
  f32x16 s1 = qk_tile(k1, L, q0, q1, q2, q3, init);
  if (MK == 2) {
#pragma unroll
    for (int v = 0; v < 16; ++v) { s0[v] += b0[(v & 3) + 8 * (v >> 2)]; s1[v] += b1[(v & 3) + 8 * (v >> 2)]; }
  }
  if (MK == 1 && kb1 != 0x7fffffff) {
    const int lo = max(0, sq - 128), hi = min(2047, sq + 128);
    const int L0 = lo - kb0 - 4 * h, H0 = hi - kb0 - 4 * h, L1 = lo - kb1 - 4 * h, H1 = hi - kb1 - 4 * h;
#pragma unroll
    for (int v = 0; v < 16; ++v) {
      const int cv = (v & 3) + 8 * (v >> 2);
      s0[v] = (cv >= L0 && cv <= H0) ? s0[v] : -1e30f;
      s1[v] = (cv >= L1 && cv <= H1) ? s1[v] : -1e30f;
    }
  }
#pragma unroll
  for (int v = 0; v < 16; ++v) s0[v] = __builtin_amdgcn_exp2f(s0[v]);
  const float a0 = (s0[0] + s0[1]) + (s0[2] + s0[3]), a1 = (s0[4] + s0[5]) + (s0[6] + s0[7]);
  const float a2 = (s0[8] + s0[9]) + (s0[10] + s0[11]), a3 = (s0[12] + s0[13]) + (s0[14] + s0[15]);
  pv_tile(v0, L, s0, st.o0, st.o1);
#pragma unroll
  for (int v = 0; v < 16; ++v) s1[v] = __builtin_amdgcn_exp2f(s1[v]);
  const float a4 = (s1[0] + s1[1]) + (s1[2] + s1[3]), a5 = (s1[4] + s1[5]) + (s1[6] + s1[7]);
  const float a6 = (s1[8] + s1[9]) + (s1[10] + s1[11]), a7 = (s1[12] + s1[13]) + (s1[14] + s1[15]);
  pv_tile(v1, L, s1, st.o0, st.o1);
  const float sum = ((a0 + a1) + (a2 + a3)) + ((a4 + a5) + (a6 + a7));
  st.l += sum;
  const float tot = sum + __shfl_xor(sum, 32);
  if (__builtin_amdgcn_ballot_w64(tot > 256.f) != 0) {
    const float delta = fmaxf(__builtin_amdgcn_logf(tot), 0.f);
    const float alpha = __builtin_amdgcn_exp2f(-delta);
    st.m += delta; st.l *= alpha;
#pragma unroll
    for (int v = 0; v < 16; ++v) { st.cinit[v] -= delta; st.o0[v] *= alpha; st.o1[v] *= alpha; }
  }
}

struct ItemD { int b, hk, nt, a0, a1; };
template <int MODE> DI ItemD item_desc(int item) {
  ItemD d; d.a0 = 0; d.a1 = 0;
  if (MODE == 0) { d.b = item >> 7; d.hk = (item >> 5) & 3; d.a0 = (item & 31) * 64 - 128; d.nt = 5; }
  else if (MODE == 1) {
    d.b = item >> 7; d.hk = (item >> 3) & 15; const int r0 = (item & 7) * 4;
    d.a0 = clampi(r0 - 4, 0, 24); d.a1 = clampi(r0 - 1, 0, 24) + 7; d.nt = 2 + ((d.a1 - d.a0 + 2) >> 1);
  } else if (MODE == 2) { d.b = item >> 4; d.hk = (item >> 2) & 3; d.nt = 2; }
  else { d.b = item >> 4; d.hk = item & 15; d.nt = 2; }
  return d;
}

template <int MODE>
DI void attn_seq(const Params& p, int layer, char* smem, const int tid, const int nitems, bf16_t* ob, const int ostride) {
  constexpr bool isA = (MODE == 0 || MODE == 2);
  constexpr bool isLat = (MODE < 2);
  constexpr int NW = isA ? 2560 : 4096, koff = 1024, voff = isA ? 1280 : 2048, goff = isA ? 1536 : 3072;
  const int jl = layer >> 1;
  const int lane = tid & 63, wv = __builtin_amdgcn_readfirstlane(tid >> 6), r = lane & 31, h = lane >> 5;
  const int item0 = (int)(((long)blockIdx.x * nitems) / (long)gridDim.x);
  const int nit = (int)(((long)(blockIdx.x + 1) * nitems) / (long)gridDim.x) - item0;
  if (nit <= 0) return;
  LAS3 char* lds = (LAS3 char*)smem;
  LAS3 const float* tab = (LAS3 const float*)(lds + ATT_TAB);
  const int hq_first = (MODE == 1) ? ((item0 >> 3) & 15) : 0;
  if (MODE == 1) {
    LAS3 float* tabw = (LAS3 float*)(lds + ATT_TAB);
    __syncthreads();
    for (int e = tid; e < TAB_FLOATS; e += NTHR) {
      float v = 0.f;
      const int t = e - TAB_HEAD0;
      if (t >= 0 && t < TAB_NH * TAB_HSTR) { const int hh = hq_first + t / TAB_HSTR, w = t % TAB_HSTR; if (w < 465 && hh < 16) v = p.b_rel_bias[((size_t)jl * 16 + hh) * 465 + w] * LOG2E; }
      if (e >= TAB_NEG) v = -1e30f;
      tabw[e] = v;
    }
  }
  const int cs_blk = (MODE == 1) ? clampi(16 * (wv & 3) - 8, 0, 32) : 0;
  auto make_lane = [&](const int cs) {
    AttnLane L;
    const int rr = r + cs, sw = swz(rr & 15);
    L.kr0 = rr * 128 + ((0 + h) ^ sw) * 16; L.kr1 = rr * 128 + ((2 + h) ^ sw) * 16; L.kr2 = rr * 128 + ((4 + h) ^ sw) * 16; L.kr3 = rr * 128 + ((6 + h) ^ sw) * 16;
    const int q = (lane & 15) >> 2, pp = lane & 3, g = (lane >> 4) & 1;
    const int ra = cs + 4 * h + q, rb = ra + 8;
    const int lp0 = 2 * g + (pp >> 1), lp1 = 4 + lp0;
    L.vr00 = ra * 128 + ((lp0 ^ swz(ra & 15)) * 16) + 8 * (pp & 1); L.vr01 = rb * 128 + ((lp0 ^ swz(rb & 15)) * 16) + 8 * (pp & 1);
    L.vr10 = ra * 128 + ((lp1 ^ swz(ra & 15)) * 16) + 8 * (pp & 1); L.vr11 = rb * 128 + ((lp1 ^ swz(rb & 15)) * 16) + 8 * (pp & 1);
    return L;
  };
  const int drow = 8 * wv + (lane >> 3);
  const int dlp = ((lane & 7) ^ swz(drow & 15)) * 8;
  auto issue = [&](const ItemD& d, int u, int stage) {
#pragma unroll
    for (int c = 0; c < 2; ++c) {
      int tok;
      if (u < 2) tok = TL + d.b * 256 + (2 * u + c) * 64 + drow;
      else if (MODE == 0) tok = d.b * 2048 + clampi(d.a0 + 64 * (2 * (u - 2) + c) + drow, 0, 2047);
      else tok = d.b * 2048 + min(d.a0 + 2 * (u - 2) + c, d.a1) * 64 + drow;
      const bf16_t* g = p.qkvg + (size_t)tok * NW + d.hk * 64 + dlp;
      __builtin_amdgcn_global_load_lds((const unsigned*)(g + koff), (LAS3 unsigned*)(lds + stage * ATT_STAGE + c * 8192 + wv * 1024), 16, 0, 0);
      __builtin_amdgcn_global_load_lds((const unsigned*)(g + voff), (LAS3 unsigned*)(lds + stage * ATT_STAGE + 16384 + c * 8192 + wv * 1024), 16, 0, 0);
    }
  };
  int gk = 0, gu = 0;
  ItemD gd = item_desc<MODE>(item0);
  int sa = 0;
  bool gvalid = true;
  auto gen_issue = [&]() {
    issue(gd, gu, sa);
    sa = (sa == ATT_NST - 1) ? 0 : sa + 1;
    if (++gu == gd.nt) { gu = 0; ++gk; if (gk < nit) gd = item_desc<MODE>(item0 + gk); else gvalid = false; }
  };
  __syncthreads();
  gen_issue();
  if (gvalid) gen_issue();
  int sc = 0, slast = 0;
#pragma unroll 1
  for (int k = 0; k < nit; ++k) {
    const int item = item0 + k;
    const ItemD d = item_desc<MODE>(item);
    int hq, tq, q0i = 0, rq = 0, cq = 0, wr_lo = 0, wr_hi = 0;
    if (MODE == 0) { hq = d.hk * 4 + (wv & 3); q0i = (item & 31) * 64 + 32 * (wv >> 2); tq = d.b * 2048 + q0i + r; }
    else if (MODE == 1) {
      hq = d.hk; const int rw = (item & 7) * 4 + 2 * (wv >> 2);
      rq = rw + (r >> 4); cq = 16 * (wv & 3) + (r & 15); tq = d.b * 2048 + rq * 64 + cq;
      wr_lo = clampi(rw - 4, 0, 24); wr_hi = clampi(rw - 3, 0, 24) + 7;
    } else if (MODE == 2) { hq = d.hk * 4 + (wv & 3); tq = TL + d.b * 256 + (item & 3) * 64 + 32 * (wv >> 2) + r; }
    else { hq = d.hk; tq = TL + d.b * 256 + wv * 32 + r; }
    {
#pragma unroll
      for (int pass = 0; pass < 4; ++pass) {
        const int row = (lane >> 3) + 8 * pass;
        int tqr;
        if (MODE == 0) tqr = d.b * 2048 + q0i + row;
        else if (MODE == 1) tqr = d.b * 2048 + ((item & 7) * 4 + 2 * (wv >> 2) + (row >> 4)) * 64 + 16 * (wv & 3) + (row & 15);
        else if (MODE == 2) tqr = TL + d.b * 256 + (item & 3) * 64 + 32 * (wv >> 2) + row;
        else tqr = TL + d.b * 256 + wv * 32 + row;
        __builtin_amdgcn_global_load_lds((const unsigned*)(p.qkvg + (size_t)tqr * NW + goff + hq * 64 + (lane & 7) * 8),
                                         (LAS3 unsigned*)(lds + ATT_GATE + wv * 4096 + pass * 1024), 16, 0, 0);
      }
    }
    const bf16_t* qp = p.qkvg + (size_t)tq * NW + hq * 64 + h * 8;
    const bf16x8 q0f = *(const bf16x8*)(qp), q1f = *(const bf16x8*)(qp + 16), q2f = *(const bf16x8*)(qp + 32), q3f = *(const bf16x8*)(qp + 48);
    AttnSt st;
#pragma unroll
    for (int v = 0; v < 16; ++v) {
      st.o0[v] = 0.f; st.o1[v] = 0.f;
      float ci = 0.f;
      if (MODE == 1) {
        const int cs_q = clampi(cq - 8, 0, 48);
        const int kc = cs_blk + crow(v, h);
        ci = (kc >= cs_q && kc < cs_q + 16) ? 0.f : -1e30f;
      }
      st.cinit[v] = ci;
    }
    st.m = 0.f; st.l = 0.f;
    const int colbase = cs_blk - cq + 15 + 4 * h;
#pragma unroll 1
    for (int u = 0; u < d.nt; ++u) {
      if (gvalid || !(k == nit - 1 && u == d.nt - 1)) asm volatile("s_waitcnt vmcnt(4)" ::: "memory");
      else asm volatile("s_waitcnt vmcnt(0)" ::: "memory");
      __builtin_amdgcn_s_barrier();
      asm volatile("" ::: "memory");
      if (gvalid) gen_issue();
      LAS3 const char* Kb = lds + sc * ATT_STAGE;
      LAS3 const char* Vb = Kb + 16384;
      slast = sc;
      sc = (sc == ATT_NST - 1) ? 0 : sc + 1;
      const AttnLane L = make_lane((MODE == 1 && u >= 2) ? cs_blk : 0);
      if (MODE == 0) {
#pragma unroll 1
        for (int c = 0; c < 2; ++c) {
          int kb0 = 0, kb1 = 0x7fffffff;
          if (u >= 2) {
            const int kbc = d.a0 + 64 * (2 * (u - 2) + c);
            if (kbc + 63 < 0 || kbc >= 2048 || kbc > q0i + 159 || kbc + 63 < q0i - 128) continue;
            const bool need_mask = (kbc < 0) || (kbc + 63 >= 2048) || (kbc < q0i + 31 - 128) || (kbc + 63 > q0i + 128);
            if (need_mask) { kb0 = kbc; kb1 = kbc + 32; }
          }
          attn_chunk<1>(Kb + c * 64 * 128, Kb + (c * 64 + 32) * 128, Vb + c * 64 * 128, Vb + (c * 64 + 32) * 128, L,
                        q0f, q1f, q2f, q3f, st, st.cinit, h, kb0, kb1, q0i + r, nullptr, nullptr);
        }
      } else if (!isLat || u < 2) {
#pragma unroll 1
        for (int c = 0; c < 2; ++c) {
          if (MODE == 1) {
            f32x16 cm;
#pragma unroll
            for (int v = 0; v < 16; ++v) cm[v] = -st.m;
            attn_chunk<0>(Kb + c * 64 * 128, Kb + (c * 64 + 32) * 128, Vb + c * 64 * 128, Vb + (c * 64 + 32) * 128, L,
                          q0f, q1f, q2f, q3f, st, cm, h, 0, 0, 0, nullptr, nullptr);
          } else {
            attn_chunk<0>(Kb + c * 64 * 128, Kb + (c * 64 + 32) * 128, Vb + c * 64 * 128, Vb + (c * 64 + 32) * 128, L,
                          q0f, q1f, q2f, q3f, st, st.cinit, h, 0, 0, 0, nullptr, nullptr);
          }
        }
      } else if (MODE == 1) {
        const int rrA = d.a0 + 2 * (u - 2), rrB = rrA + 1;
        const bool inA = (rrA >= wr_lo) && (rrA <= wr_hi), inB = (rrB >= wr_lo) && (rrB <= wr_hi) && (rrB <= d.a1);
        if (inA || inB) {
          const int rs_q = clampi(rq - 4, 0, 24);
          const bool okA = (rrA >= rs_q) && (rrA < rs_q + 8), okB = (rrB >= rs_q) && (rrB < rs_q + 8) && (rrB <= d.a1);
          LAS3 const float* bA = (okA ? (tab + TAB_HEAD0 + (hq - hq_first) * TAB_HSTR + (rrA - rq + 7) * 31) : (tab + TAB_NEG + 32)) + colbase;
          LAS3 const float* bB = (okB ? (tab + TAB_HEAD0 + (hq - hq_first) * TAB_HSTR + (rrB - rq + 7) * 31) : (tab + TAB_NEG + 32)) + colbase;
          attn_chunk<2>(Kb, Kb + 64 * 128, Vb, Vb + 64 * 128, L, q0f, q1f, q2f, q3f, st, st.cinit, h, 0, 0, 0, bA, bB);
        }
      }
    }
    float lsum = st.l + __shfl_xor(st.l, 32);
    if (isA) lsum += __builtin_amdgcn_exp2f(p.a_sink[jl * 16 + hq] * LOG2E - st.m);
    const float inv = 1.f / lsum;
    LAS3 char* scr = lds + ATT_GATE + wv * 4096;
    u32x4 gv0, gv1, gv2, gv3;
    gv0 = *(LAS3 const u32x4*)(scr + 0 * 1024 + lane * 16); gv1 = *(LAS3 const u32x4*)(scr + 1 * 1024 + lane * 16);
    gv2 = *(LAS3 const u32x4*)(scr + 2 * 1024 + lane * 16); gv3 = *(LAS3 const u32x4*)(scr + 3 * 1024 + lane * 16);
    asm volatile("s_waitcnt lgkmcnt(0)" ::: "memory");
    {
      const int swr = swz(r & 15);
#pragma unroll
      for (int g4 = 0; g4 < 4; ++g4) {
        u32x2 w0, w1;
        w0[0] = pk2(st.o0[4 * g4 + 0] * inv, st.o0[4 * g4 + 1] * inv); w0[1] = pk2(st.o0[4 * g4 + 2] * inv, st.o0[4 * g4 + 3] * inv);
        w1[0] = pk2(st.o1[4 * g4 + 0] * inv, st.o1[4 * g4 + 1] * inv); w1[1] = pk2(st.o1[4 * g4 + 2] * inv, st.o1[4 * g4 + 3] * inv);
        *(LAS3 u32x2*)(scr + r * 128 + ((g4 ^ swr) * 16) + 8 * h) = w0;
        *(LAS3 u32x2*)(scr + r * 128 + (((4 + g4) ^ swr) * 16) + 8 * h) = w1;
      }
    }
#pragma unroll
    for (int pass = 0; pass < 4; ++pass) {
      const int row = (lane >> 3) + 8 * pass, piece = lane & 7;
      const u32x4 ov = *(LAS3 const u32x4*)(scr + row * 128 + ((piece ^ swz(row & 15)) * 16));
      int tqr;
      if (MODE == 0) tqr = d.b * 2048 + q0i + row;
      else if (MODE == 1) tqr = d.b * 2048 + ((item & 7) * 4 + 2 * (wv >> 2) + (row >> 4)) * 64 + 16 * (wv & 3) + (row & 15);
      else if (MODE == 2) tqr = TL + d.b * 256 + (item & 3) * 64 + 32 * (wv >> 2) + row;
      else tqr = TL + d.b * 256 + wv * 32 + row;
      const u32x4 gv = (pass == 0) ? gv0 : (pass == 1) ? gv1 : (pass == 2) ? gv2 : gv3;
      uint4 w;
      w.x = pk2(bflo(ov[0]) * bflo(gv[0]), bfhi(ov[0]) * bfhi(gv[0]));
      w.y = pk2(bflo(ov[1]) * bflo(gv[1]), bfhi(ov[1]) * bfhi(gv[1]));
      w.z = pk2(bflo(ov[2]) * bflo(gv[2]), bfhi(ov[2]) * bfhi(gv[2]));
      w.w = pk2(bflo(ov[3]) * bflo(gv[3]), bfhi(ov[3]) * bfhi(gv[3]));
      *(uint4*)(ob + (size_t)tqr * ostride + hq * 64 + piece * 8) = w;
    }
    asm volatile("s_waitcnt lgkmcnt(0)" ::: "memory");
  }
}

DI void attn_phase(const Params& p, int layer, char* smem, bf16_t* ob, const int ostride) {
  const bool isA = !(layer & 1);
  const bool ctx_out = layer < 3;
  if (isA) {
    { const int tid = opaque_tid(); attn_seq<0>(p, layer, smem, tid, 4096, ob, ostride); }
    if (ctx_out) { const int tid = opaque_tid(); attn_seq<2>(p, layer, smem, tid, 512, ob, ostride); }
  } else {
    { const int tid = opaque_tid(); attn_seq<1>(p, layer, smem, tid, 4096, ob, ostride); }
    if (ctx_out) { const int tid = opaque_tid(); attn_seq<3>(p, layer, smem, tid, 512, ob, ostride); }
  }
  __syncthreads();
}

#define XB_TMO      128
#define XB_XCNT(j)  (256  + 64 * (j))
#define XB_XSUB(j)  (1280 + 64 * (j))
#define XB_XGEN(j)  (2304 + 64 * (j))
#define XB_TOP      3328
#define XB_TOPGEN   3392
#define XCD_BAR_WORDS 3456
#define XB_SPIN_CAP (1u << 18)
DI unsigned xb_ld(unsigned* p)              { return __hip_atomic_load(p, __ATOMIC_RELAXED, __HIP_MEMORY_SCOPE_AGENT); }
DI unsigned xb_add(unsigned* p, unsigned v) { return __hip_atomic_fetch_add(p, v, __ATOMIC_RELAXED, __HIP_MEMORY_SCOPE_AGENT); }
DI unsigned xb_xcc_id() { return (unsigned)__builtin_amdgcn_s_getreg((3 << 11) | 20) & 0xFu; }
#define XB_SPIN(cond, bar) do { unsigned _sp = 0; while (cond) { __builtin_amdgcn_s_sleep(1); \
    if ((++_sp & 255u) == 0u) { if (xb_ld(&(bar)[XB_TMO])) break; if (_sp > XB_SPIN_CAP) { atomicAdd(&(bar)[XB_TMO], 1u); break; } } } } while (0)
DI void xcd_barrier_post(unsigned* bar) { if (threadIdx.x == 0) (void)xb_add(&bar[XB_XCNT(xb_xcc_id())], 1u); }
DI void xcd_barrier_complete(unsigned* bar, unsigned x, unsigned& nloc, unsigned& nx) {
  const unsigned G = gridDim.x;
  unsigned sum, cnt, mine, sp = 0u;
  for (;;) {
    sum = 0u; cnt = 0u; mine = 0u;
#pragma unroll
    for (unsigned j = 0; j < 16; ++j) { const unsigned c = xb_ld(&bar[XB_XCNT(j)]); sum += c; cnt += (c > 0u) ? 1u : 0u; mine = (j == x) ? c : mine; }
    if (sum == G) break;
    __builtin_amdgcn_s_sleep(1);
    if ((++sp & 255u) == 0u) { if (xb_ld(&bar[XB_TMO])) break; if (sp > XB_SPIN_CAP) { atomicAdd(&bar[XB_TMO], 1u); break; } }
  }
  nloc = mine > 0u ? mine : 1u; nx = cnt > 0u ? cnt : 1u;
}
DI void xcd_barrier(unsigned* bar, volatile LAS3 unsigned* st) {
  asm volatile("s_waitcnt vmcnt(0)" ::: "memory");
  __syncthreads();
  if (threadIdx.x == 0) {
    const unsigned x = xb_xcc_id();
    __builtin_amdgcn_s_waitcnt(0);
    unsigned nloc = st[0], nx = st[1];
    if (nloc == 0u) { xcd_barrier_complete(bar, x, nloc, nx); st[0] = nloc; st[1] = nx; }
    const unsigned old = xb_add(&bar[XB_XSUB(x)], 1u);
    const unsigned gen = old / nloc;
    if (old + 1u == (gen + 1u) * nloc) {
      __builtin_amdgcn_fence(__ATOMIC_RELEASE, "agent");
      asm volatile("s_waitcnt vmcnt(0)" ::: "memory");
      const unsigned og = xb_add(&bar[XB_TOP], 1u);
      const unsigned tg = og / nx;
      if (og + 1u == (tg + 1u) * nx) xb_add(&bar[XB_TOPGEN], 1u);
      else XB_SPIN(xb_ld(&bar[XB_TOPGEN]) == tg, bar);
      __builtin_amdgcn_fence(__ATOMIC_ACQUIRE, "agent");
      xb_add(&bar[XB_XGEN(x)], 1u);
      asm volatile("s_waitcnt vmcnt(0)" ::: "memory");
    } else {
      XB_SPIN(xb_ld(&bar[XB_XGEN(x)]) == gen, bar);
      __builtin_amdgcn_fence(__ATOMIC_ACQUIRE, "agent");
      asm volatile("s_waitcnt vmcnt(0)" ::: "memory");
    }
  }
  __syncthreads();
}

typedef _Float16 h16x2 __attribute__((ext_vector_type(2)));
DI unsigned pkh2(float lo, float hi) { f32x2 v = {lo, hi}; return __builtin_bit_cast(unsigned, __builtin_convertvector(v, h16x2)); }
DI float hlo(unsigned u) { return (float)__builtin_bit_cast(h16x2, u)[0]; }
DI float hhi(unsigned u) { return (float)__builtin_bit_cast(h16x2, u)[1]; }
struct LnVec { float4 a, b, c, d; };
DI LnVec ln_ldvec(const float* v, int c0) { LnVec r; r.a = *(const float4*)(v + c0); r.b = *(const float4*)(v + c0 + 4); r.c = *(const float4*)(v + 512 + c0); r.d = *(const float4*)(v + 512 + c0 + 4); return r; }
DI float4 ld_nt4(const float* p) { const f32x4 v = __builtin_nontemporal_load((const f32x4*)p); return make_float4(v[0], v[1], v[2], v[3]); }
DI float4 h4lo(const u32x4 v) { return make_float4(hlo(v[0]), hhi(v[0]), hlo(v[1]), hhi(v[1])); }
DI float4 h4hi(const u32x4 v) { return make_float4(hlo(v[2]), hhi(v[2]), hlo(v[3]), hhi(v[3])); }
DI float4 b4lo(const uint4 v) { return make_float4(bflo(v.x), bfhi(v.x), bflo(v.y), bfhi(v.y)); }
DI float4 b4hi(const uint4 v) { return make_float4(bflo(v.z), bfhi(v.z), bflo(v.w), bfhi(v.w)); }
DI float4 zmix(const float4 h, const float4 g, const float4 y) { return make_float4(ALPHA * h.x + g.x * y.x, ALPHA * h.y + g.y * y.y, ALPHA * h.z + g.z * y.z, ALPHA * h.w + g.w * y.w); }
DI float sq4(float4 z, float mean) {
  float a = z.x - mean, b = z.y - mean, c = z.z - mean, d = z.w - mean;
  return a * a + b * b + c * c + d * d;
}
struct LnRow { float4 z0, z1, z2, z3; };
template <bool IN16>
DI LnRow ln_load(const float* hin, const unsigned short* hin16, const bf16_t* yu, const LnVec& gate, int c0) {
  LnRow r;
  const uint4 ya = *(const uint4*)(yu + c0), yb = *(const uint4*)(yu + 512 + c0);
  float4 h0, h1, h2, h3;
  if (IN16) {
    const u32x4 ha = __builtin_nontemporal_load((const u32x4*)(hin16 + c0)), hb = __builtin_nontemporal_load((const u32x4*)(hin16 + 512 + c0));
    h0 = h4lo(ha); h1 = h4hi(ha); h2 = h4lo(hb); h3 = h4hi(hb);
  } else {
    h0 = ld_nt4(hin + c0); h1 = ld_nt4(hin + c0 + 4); h2 = ld_nt4(hin + 512 + c0); h3 = ld_nt4(hin + 512 + c0 + 4);
  }
  r.z0 = zmix(h0, gate.a, b4lo(ya)); r.z1 = zmix(h1, gate.b, b4hi(ya)); r.z2 = zmix(h2, gate.c, b4lo(yb)); r.z3 = zmix(h3, gate.d, b4hi(yb));
  return r;
}
DI float4 ln_norm(const float4 z, float mean, float rstd, const float4 g, const float4 b) {
  return make_float4((z.x - mean) * rstd * g.x + b.x, (z.y - mean) * rstd * g.y + b.y, (z.z - mean) * rstd * g.z + b.z, (z.w - mean) * rstd * g.w + b.w);
}
DI unsigned umod(float a, float b, float sca, float scb, float sha, float shb) { return pk2(a * (1.f + sca) + sha, b * (1.f + scb) + shb); }
template <bool OUT16>
DI void ln_finish(const LnRow& r, float* hout, unsigned short* hout16, bf16_t* yu, const LnVec& g, const LnVec& b, const LnVec& sc, const LnVec& sh, int c0, bool wr_u) {
  const float sum = (r.z0.x + r.z0.y + r.z0.z + r.z0.w) + (r.z1.x + r.z1.y + r.z1.z + r.z1.w) + (r.z2.x + r.z2.y + r.z2.z + r.z2.w) + (r.z3.x + r.z3.y + r.z3.z + r.z3.w);
  const float mean = wave_sum(sum) * (1.f / 1024.f);
  const float sq = sq4(r.z0, mean) + sq4(r.z1, mean) + sq4(r.z2, mean) + sq4(r.z3, mean);
  const float rstd = rsqrtf(wave_sum(sq) * (1.f / 1024.f) + 1e-5f);
  const float4 o0 = ln_norm(r.z0, mean, rstd, g.a, b.a), o1 = ln_norm(r.z1, mean, rstd, g.b, b.b), o2 = ln_norm(r.z2, mean, rstd, g.c, b.c), o3 = ln_norm(r.z3, mean, rstd, g.d, b.d);
  if (OUT16) {
    u32x4 wa, wb;
    wa[0] = pkh2(o0.x, o0.y); wa[1] = pkh2(o0.z, o0.w); wa[2] = pkh2(o1.x, o1.y); wa[3] = pkh2(o1.z, o1.w);
    wb[0] = pkh2(o2.x, o2.y); wb[1] = pkh2(o2.z, o2.w); wb[2] = pkh2(o3.x, o3.y); wb[3] = pkh2(o3.z, o3.w);
    __builtin_nontemporal_store(wa, (u32x4*)(hout16 + c0));
    __builtin_nontemporal_store(wb, (u32x4*)(hout16 + 512 + c0));
  } else {
    f32x4 v;
    v[0] = o0.x; v[1] = o0.y; v[2] = o0.z; v[3] = o0.w; __builtin_nontemporal_store(v, (f32x4*)(hout + c0));
    v[0] = o1.x; v[1] = o1.y; v[2] = o1.z; v[3] = o1.w; __builtin_nontemporal_store(v, (f32x4*)(hout + c0 + 4));
    v[0] = o2.x; v[1] = o2.y; v[2] = o2.z; v[3] = o2.w; __builtin_nontemporal_store(v, (f32x4*)(hout + 512 + c0));
    v[0] = o3.x; v[1] = o3.y; v[2] = o3.z; v[3] = o3.w; __builtin_nontemporal_store(v, (f32x4*)(hout + 512 + c0 + 4));
  }
  if (wr_u) {
    uint4 ua, ub;
    ua.x = umod(o0.x, o0.y, sc.a.x, sc.a.y, sh.a.x, sh.a.y); ua.y = umod(o0.z, o0.w, sc.a.z, sc.a.w, sh.a.z, sh.a.w);
    ua.z = umod(o1.x, o1.y, sc.b.x, sc.b.y, sh.b.x, sh.b.y); ua.w = umod(o1.z, o1.w, sc.b.z, sc.b.w, sh.b.z, sh.b.w);
    ub.x = umod(o2.x, o2.y, sc.c.x, sc.c.y, sh.c.x, sh.c.y); ub.y = umod(o2.z, o2.w, sc.c.z, sc.c.w, sh.c.z, sh.c.w);
    ub.z = umod(o3.x, o3.y, sc.d.x, sc.d.y, sh.d.x, sh.d.y); ub.w = umod(o3.z, o3.w, sc.d.z, sc.d.w, sh.d.z, sh.d.w);
    *(uint4*)(yu + c0) = ua;
    *(uint4*)(yu + 512 + c0) = ub;
  }
}
template <bool IN16, bool OUT16>
DI void ln_body(const Params& p, int layer) {
  const int tid = opaque_tid(), lane = tid & 63, wave = __builtin_amdgcn_readfirstlane(tid >> 6);
  const int nrows = (layer < 3) ? TT : TL;
  const bool wr_u = layer < 3;
  const int c0 = lane * 8;
  const float* lgp = p.ln_g + layer * 1024;
  const float* lbp = p.ln_b + layer * 1024;
  const int nw = gridDim.x * 8, gw = blockIdx.x * 8 + wave;
  const int r_lo = (int)(((long)gw * nrows) / nw), r_hi = (int)(((long)(gw + 1) * nrows) / nw);
  constexpr bool in16 = IN16, out16 = OUT16;
  int bcur = -1;
  LnVec gate = ln_ldvec(lgp, c0);
  const float* md2 = p.mod;
#pragma unroll 1
  for (int row = r_lo; row < r_hi; row += 4) {
    const int nr = min(4, r_hi - row);
    const int bq = (row >= TL) ? 32 : (row >> 11);
    const int bl = (row + nr - 1 >= TL) ? 32 : ((row + nr - 1) >> 11);
    if (bq != bl || nr < 4) {
      for (int j = 0; j < nr; ++j) {
        const int rj = row + j;
        const bool isctx = rj >= TL;
        const int b = isctx ? 32 : (rj >> 11);
        if (b != bcur) {
          bcur = b;
          const float* md = p.mod + ((size_t)layer * 33 + b) * 3072;
          md2 = p.mod + ((size_t)(wr_u ? layer + 1 : layer) * 33 + b) * 3072;
          gate = ln_ldvec(md + 2048, c0);
        }
        const float* hin = isctx ? (p.ctx + (size_t)(rj - TL) * 1024) : (p.x + (size_t)rj * 1024);
        const unsigned short* hin16 = in16 ? (p.h16 + (size_t)rj * 1024) : nullptr;
        float* hout = p.out + (size_t)(isctx ? 0 : rj) * 1024;
        unsigned short* hout16 = out16 ? (p.h16 + (size_t)rj * 1024) : nullptr;
        bf16_t* yu = p.u + (size_t)rj * 1024;
        const LnRow ra = ln_load<IN16>(hin, hin16, yu, gate, c0);
        const LnVec g = ln_ldvec(lgp, c0), bb = ln_ldvec(lbp, c0), sc = ln_ldvec(md2 + 1024, c0), sh = ln_ldvec(md2, c0);
        ln_finish<OUT16>(ra, hout, hout16, yu, g, bb, sc, sh, c0, wr_u);
      }
      continue;
    }
    if (bq != bcur) {
      bcur = bq;
      const float* md = p.mod + ((size_t)layer * 33 + bq) * 3072;
      md2 = p.mod + ((size_t)(wr_u ? layer + 1 : layer) * 33 + bq) * 3072;
      gate = ln_ldvec(md + 2048, c0);
    }
    const bool isctx = row >= TL;
    const float* hin = isctx ? (p.ctx + (size_t)(row - TL) * 1024) : (p.x + (size_t)row * 1024);
    const unsigned short* hin16 = in16 ? (p.h16 + (size_t)row * 1024) : nullptr;
    float* hout = p.out + (size_t)(isctx ? 0 : row) * 1024;
    unsigned short* hout16 = out16 ? (p.h16 + (size_t)row * 1024) : nullptr;
    bf16_t* yu = p.u + (size_t)row * 1024;
    const unsigned short* hb = hin16 ? hin16 + 1024 : nullptr; const unsigned short* hc_ = hin16 ? hin16 + 2048 : nullptr; const unsigned short* hd = hin16 ? hin16 + 3072 : nullptr;
    const LnRow ra = ln_load<IN16>(hin, hin16, yu, gate, c0), rb = ln_load<IN16>(hin + 1024, hb, yu + 1024, gate, c0), rc = ln_load<IN16>(hin + 2048, hc_, yu + 2048, gate, c0), rd = ln_load<IN16>(hin + 3072, hd, yu + 3072, gate, c0);
    const LnVec g = ln_ldvec(lgp, c0), bb = ln_ldvec(lbp, c0), sc = ln_ldvec(md2 + 1024, c0), sh = ln_ldvec(md2, c0);
    ln_finish<OUT16>(ra, hout, hout16, yu, g, bb, sc, sh, c0, wr_u);
    ln_finish<OUT16>(rb, hout + 1024, hout16 ? hout16 + 1024 : nullptr, yu + 1024, g, bb, sc, sh, c0, wr_u);
    ln_finish<OUT16>(rc, hout + 2048, hout16 ? hout16 + 2048 : nullptr, yu + 2048, g, bb, sc, sh, c0, wr_u);
    ln_finish<OUT16>(rd, hout + 3072, hout16 ? hout16 + 3072 : nullptr, yu + 3072, g, bb, sc, sh, c0, wr_u);
  }
}

DI void ln_phase(const Params& p, int layer) {
  if (layer == 0) ln_body<false, true>(p, layer);
  else if (layer < 3) ln_body<true, true>(p, layer);
  else ln_body<true, false>(p, layer);
}

__global__ void __launch_bounds__(512, 2) mega(Params p, int ph_lo, int ph_hi) {
  extern __shared__ __attribute__((aligned(16))) char smem[];
  volatile LAS3 unsigned* bst = (volatile LAS3 unsigned*)(smem + SMEM_BAR);
  if (ph_hi - ph_lo > 1) {
    if (threadIdx.x == 0) { bst[0] = 0u; bst[1] = 0u; }
    __syncthreads();
    xcd_barrier_post(p.bar);
  }
  for (int ph = ph_lo; ph < ph_hi; ++ph) {
    if (ph == 0) phase_prep(p, (float*)smem);
    else if (ph == 1) phase_mod0(p);
    else {
      const int layer = (ph - 2) >> 2, sub = (ph - 2) & 3;
      const bool isA = !(layer & 1);
      const int jl = layer >> 1;
      const int NW = isA ? 2560 : 4096;
      if (sub == 0) {
        if (isA) gemm_phase<EPI_A>(p, p.u, 1024, p.wt_a_in + (size_t)jl * 2560 * 1024, TT, 2560, smem);
        else if (layer < 3) gemm_phase<EPI_B>(p, p.u, 1024, p.wt_b_in + (size_t)jl * 4096 * 1024, TT, 4096, smem);
        else {
          gemm_phase<EPI_B>(p, p.u, 1024, p.wt_b_in + (size_t)jl * 4096 * 1024, TL, 4096, smem);
          gemm_phase<EPI_B>(p, p.u + (size_t)TL * 1024, 1024, p.wt_b_in + (size_t)jl * 4096 * 1024 + (size_t)1024 * 1024, TC, 2048, smem, 256, 4);
        }
      } else if (sub == 1) {
        attn_phase(p, layer, smem, p.qkvg + (isA ? 1536 : 3072), NW);
      } else if (sub == 2) {
        const int M = (layer < 3) ? TT : TL;
        const int goff = isA ? 1536 : 3072;
        gemm_phase<EPI_OUT>(p, p.qkvg + goff, NW, (isA ? p.wt_a_out : p.wt_b_out) + (size_t)jl * 1024 * 1024, M, 1024, smem);
      } else {
        ln_phase(p, layer);
      }
    }
    if (ph + 1 < ph_hi) { if (ph_hi > 1000) cg::this_grid().sync(); else xcd_barrier(p.bar, bst); }
  }
}

extern "C" void kernel_launch(void* const* d_in, const int* in_sizes, int n_in, void* d_out, int out_size, void* d_ws, size_t ws_size,
                              hipStream_t stream) {
  static int grid_blocks = 0;
  if (!grid_blocks) {
    int dev = 0, cus = 0, per_cu = 0;
    (void)hipGetDevice(&dev);
    (void)hipDeviceGetAttribute(&cus, hipDeviceAttributeMultiprocessorCount, dev);
    (void)hipFuncSetAttribute((const void*)mega, hipFuncAttributeMaxDynamicSharedMemorySize, SMEM_BYTES);
    (void)hipOccupancyMaxActiveBlocksPerMultiprocessor(&per_cu, mega, NTHR, SMEM_BYTES);
    if (per_cu < 1) per_cu = 1;
    grid_blocks = cus * per_cu;
  }
  Params p{};
  p.x = (const float*)d_in[0]; p.c = (const float*)d_in[1]; p.ctx = (const float*)d_in[2]; p.c_ctx = (const float*)d_in[3];
  p.w_ada = (const float*)d_in[4]; p.b_ada = (const float*)d_in[5]; p.ln_g = (const float*)d_in[6]; p.ln_b = (const float*)d_in[7];
  p.a_w_in = (const float*)d_in[8]; p.a_w_out = (const float*)d_in[9]; p.a_sink = (const float*)d_in[10];
  p.b_w_in = (const float*)d_in[11]; p.b_w_out = (const float*)d_in[12]; p.b_rel_bias = (const float*)d_in[13];
  p.out = (float*)d_out;
  char* w = (char*)d_ws;
  size_t off = 0;
  auto take = [&](size_t bytes) { char* r = w + off; off += (bytes + 255) & ~(size_t)255; return r; };
  p.hc = (float*)take((size_t)TC * 1024 * 4);
  p.u = (bf16_t*)take((size_t)TT * 1024 * 2);
  p.qkvg = (bf16_t*)take((size_t)TT * 4096 * 2);
  p.h16 = (unsigned short*)take((size_t)TT * 1024 * 2);
  p.wt_a_in = (bf16_t*)take((size_t)2 * 2560 * 1024 * 2);
  p.wt_a_out = (bf16_t*)take((size_t)2 * 1024 * 1024 * 2);
  p.wt_b_in = (bf16_t*)take((size_t)2 * 4096 * 1024 * 2);
  p.wt_b_out = (bf16_t*)take((size_t)2 * 1024 * 1024 * 2);
  p.mod = (float*)take((size_t)5 * 33 * 3072 * 4);
  p.rope = (float*)take((size_t)64 * 16 * 2 * 4);
  p.bar = (unsigned*)take((size_t)XCD_BAR_WORDS * 4);
  if (off > ws_size) { fprintf(stderr, "workspace too small: need %zu have %zu\n", off, ws_size); return; }
#if MK_COOP
  (void)hipMemsetAsync(p.bar, 0, (size_t)XCD_BAR_WORDS * 4, stream);
  int lo = 0, hi = NPHASE;
  void* args[] = {&p, &lo, &hi};
  hipError_t e = hipLaunchCooperativeKernel((void*)mega, dim3(grid_blocks), dim3(NTHR), args, SMEM_BYTES, stream);
  if (e != hipSuccess) fprintf(stderr, "cooperative launch failed: %s (grid %d)\n", hipGetErrorString(e), grid_blocks);
#else
  for (int ph = 0; ph < NPHASE; ++ph) hipLaunchKernelGGL(mega, dim3(grid_blocks), dim3(NTHR), SMEM_BYTES, stream, p, ph, ph + 1);
#endif
}
```

```cpp
#include <hip/hip_runtime.h>
#include <hip/hip_cooperative_groups.h>
#include <cstdio>
namespace cg = cooperative_groups;

#ifndef MK_COOP
#define MK_COOP 1
#endif

typedef unsigned short bf16_t;
typedef short bf16x8 __attribute__((ext_vector_type(8)));
typedef float f32x16 __attribute__((ext_vector_type(16)));
typedef float f32x2 __attribute__((ext_vector_type(2)));
typedef __bf16 bf16x2v __attribute__((ext_vector_type(2)));
typedef float f32x4 __attribute__((ext_vector_type(4)));
typedef unsigned u32x4 __attribute__((ext_vector_type(4)));
typedef unsigned u32x2 __attribute__((ext_vector_type(2)));

#define DI __device__ __forceinline__
#define LAS3 __attribute__((address_space(3)))

constexpr int NB = 32, SEQ = 2048, DM = 1024, CTXL = 256;
constexpr int TL = NB * SEQ;
constexpr int TC = NB * CTXL;
constexpr int TT = TL + TC;
constexpr int NPHASE = 18;
constexpr float ALPHA = 1.681792830507429f;
constexpr int SMEM_BYTES = 98304 + 32768 + 8704 + 16;
constexpr int SMEM_BAR = 98304 + 32768 + 8704;
constexpr int NTHR = 512;

DI unsigned pk2(float lo, float hi) { f32x2 v = {lo, hi}; return __builtin_bit_cast(unsigned, __builtin_convertvector(v, bf16x2v)); }
DI float bf2f(bf16_t x) { return __uint_as_float(((unsigned)x) << 16); }
DI float bflo(unsigned u) { return __uint_as_float(u << 16); }
DI float bfhi(unsigned u) { return __uint_as_float(u & 0xffff0000u); }
DI float silu_f(float x) { return x * __builtin_amdgcn_rcpf(1.f + __expf(-x)); }
DI float wave_sum(float v) {
#pragma unroll
  for (int o = 32; o > 0; o >>= 1) v += __shfl_xor(v, o);
  return v;
}
DI float wave_max(float v) {
#pragma unroll
  for (int o = 32; o > 0; o >>= 1) v = fmaxf(v, __shfl_xor(v, o));
  return v;
}
DI int opaque_tid() { int t = threadIdx.x; asm volatile("" : "+v"(t)); return t; }
DI int clampi(int x, int lo, int hi) { return x < lo ? lo : (x > hi ? hi : x); }

struct Params {
  const float *x, *c, *ctx, *c_ctx, *w_ada, *b_ada, *ln_g, *ln_b, *a_w_in, *a_w_out, *a_sink, *b_w_in, *b_w_out, *b_rel_bias;
  float* out;
  float* hc;
  bf16_t* u;
  bf16_t* qkvg;
  unsigned short* h16;
  bf16_t* wt_a_in;
  bf16_t* wt_a_out;
  bf16_t* wt_b_in;
  bf16_t* wt_b_out;
  float* mod;
  float* rope;
  unsigned* bar;
};

DI void prep_mod_item(const Params& p, int item, float* smem) {
  const int tid = opaque_tid(), lane = tid & 63, wv = tid >> 6;
  const int layer = item / 48, cgp = item % 48;
  const int col = cgp * 64 + lane;
  float acc[33];
#pragma unroll
  for (int b = 0; b < 33; ++b) acc[b] = 0.f;
  const float* W = p.w_ada + (size_t)layer * 1024 * 3072;
#pragma unroll 1
  for (int half = 0; half < 2; ++half) {
    __syncthreads();
    for (int e = tid; e < 33 * 512; e += NTHR) {
      const int kk = e & 511, b = e >> 9;
      const int k = half * 512 + kk;
      const float v = (b < 32) ? p.c[b * 1024 + k] : p.c_ctx[k];
      smem[e] = silu_f(v);
    }
    __syncthreads();
    const float* Wh = W + (size_t)(half * 512 + wv * 64) * 3072 + col;
    const float* sg = smem + wv * 64;
#pragma unroll 8
    for (int kk = 0; kk < 64; ++kk) {
      const float w = Wh[(size_t)kk * 3072];
#pragma unroll
      for (int b = 0; b < 33; ++b) acc[b] += sg[b * 512 + kk] * w;
    }
  }
  __syncthreads();
#pragma unroll
  for (int b = 0; b < 33; ++b) smem[(wv * 33 + b) * 64 + lane] = acc[b];
  __syncthreads();
  for (int e = tid; e < 33 * 64; e += NTHR) {
    const int l = e & 63, b = e >> 6;
    float s = 0.f;
#pragma unroll
    for (int w = 0; w < 8; ++w) s += smem[(w * 33 + b) * 64 + l];
    const int cc = cgp * 64 + l;
    p.mod[((size_t)layer * 33 + b) * 3072 + cc] = s + p.b_ada[layer * 3072 + cc];
  }
  __syncthreads();
}

DI void prep_transpose_item(const float* W, bf16_t* Wt, int N, int kt, int ng, float* smem) {
  const int tid = opaque_tid();
  __syncthreads();
#pragma unroll
  for (int t = 0; t < 4; ++t)
#pragma unroll
    for (int i = 0; i < 8; ++i) {
      const int kl = i * 8 + (tid >> 6), nl = tid & 63;
      smem[t * (64 * 65) + kl * 65 + nl] = W[(size_t)(kt * 64 + kl) * N + ng * 256 + t * 64 + nl];
    }
  __syncthreads();
#pragma unroll
  for (int i = 0; i < 4; ++i) {
    const int c = tid + i * NTHR;
    const int n = c >> 3, kg = c & 7;
    const float* s = smem + (n >> 6) * (64 * 65) + (kg * 8) * 65 + (n & 63);
    uint4 w;
    w.x = pk2(s[0 * 65], s[1 * 65]); w.y = pk2(s[2 * 65], s[3 * 65]); w.z = pk2(s[4 * 65], s[5 * 65]); w.w = pk2(s[6 * 65], s[7 * 65]);
    *(uint4*)(Wt + (size_t)(ng * 256 + n) * 1024 + kt * 64 + kg * 8) = w;
  }
}

DI void phase_prep(const Params& p, float* smem) {
  const int n_ain = 2 * 16 * 10, n_aout = 2 * 16 * 4, n_bin = 2 * 16 * 16, n_bout = 2 * 16 * 4;
  const int total = n_ain + n_aout + n_bin + n_bout + 192 + 1;
  for (int item = blockIdx.x; item < total; item += gridDim.x) {
    int it = item;
    if (it < n_ain) { int l = it / 160, r = it % 160; prep_transpose_item(p.a_w_in + (size_t)l * 1024 * 2560, p.wt_a_in + (size_t)l * 2560 * 1024, 2560, r / 10, r % 10, smem); continue; }
    it -= n_ain;
    if (it < n_aout) { int l = it / 64, r = it % 64; prep_transpose_item(p.a_w_out + (size_t)l * 1024 * 1024, p.wt_a_out + (size_t)l * 1024 * 1024, 1024, r / 4, r % 4, smem); continue; }
    it -= n_aout;
    if (it < n_bin) { int l = it / 256, r = it % 256; prep_transpose_item(p.b_w_in + (size_t)l * 1024 * 4096, p.wt_b_in + (size_t)l * 4096 * 1024, 4096, r / 16, r % 16, smem); continue; }
    it -= n_bin;
    if (it < n_bout) { int l = it / 64, r = it % 64; prep_transpose_item(p.b_w_out + (size_t)l * 1024 * 1024, p.wt_b_out + (size_t)l * 1024 * 1024, 1024, r / 4, r % 4, smem); continue; }
    it -= n_bout;
    if (it < 192) { prep_mod_item(p, it, smem); continue; }
    for (int e = opaque_tid(); e < 64 * 16; e += NTHR) {
      int pos = e >> 4, j = e & 15;
      float inv = powf(10000.0f, -(float)j / 16.0f);
      float ang = (float)pos * inv;
      p.rope[e * 2 + 0] = cosf(ang);
      p.rope[e * 2 + 1] = sinf(ang);
    }
  }
}

DI void mod0_row(const float* src, bf16_t* dst, int c0, const float4 sc0, const float4 sc1, const float4 sc2, const float4 sc3,
                 const float4 sh0, const float4 sh1, const float4 sh2, const float4 sh3) {
  const f32x4 v0 = __builtin_nontemporal_load((const f32x4*)(src + c0)), v1 = __builtin_nontemporal_load((const f32x4*)(src + c0 + 256));
  const f32x4 v2 = __builtin_nontemporal_load((const f32x4*)(src + c0 + 512)), v3 = __builtin_nontemporal_load((const f32x4*)(src + c0 + 768));
  uint2 o;
  o.x = pk2(v0[0] * (1.f + sc0.x) + sh0.x, v0[1] * (1.f + sc0.y) + sh0.y); o.y = pk2(v0[2] * (1.f + sc0.z) + sh0.z, v0[3] * (1.f + sc0.w) + sh0.w);
  *(uint2*)(dst + c0) = o;
  o.x = pk2(v1[0] * (1.f + sc1.x) + sh1.x, v1[1] * (1.f + sc1.y) + sh1.y); o.y = pk2(v1[2] * (1.f + sc1.z) + sh1.z, v1[3] * (1.f + sc1.w) + sh1.w);
  *(uint2*)(dst + c0 + 256) = o;
  o.x = pk2(v2[0] * (1.f + sc2.x) + sh2.x, v2[1] * (1.f + sc2.y) + sh2.y); o.y = pk2(v2[2] * (1.f + sc2.z) + sh2.z, v2[3] * (1.f + sc2.w) + sh2.w);
  *(uint2*)(dst + c0 + 512) = o;
  o.x = pk2(v3[0] * (1.f + sc3.x) + sh3.x, v3[1] * (1.f + sc3.y) + sh3.y); o.y = pk2(v3[2] * (1.f + sc3.z) + sh3.z, v3[3] * (1.f + sc3.w) + sh3.w);
  *(uint2*)(dst + c0 + 768) = o;
}
DI void phase_mod0(const Params& p) {
  const int tid = opaque_tid(), lane = tid & 63, wave = __builtin_amdgcn_readfirstlane(tid >> 6);
  const int c0 = lane * 4;
  const int nw = gridDim.x * 8, gw = blockIdx.x * 8 + wave;
  const int r_lo = (int)(((long)gw * TT) / nw), r_hi = (int)(((long)(gw + 1) * TT) / nw);
  int bcur = -1;
  float4 sc0, sc1, sc2, sc3, sh0, sh1, sh2, sh3;
  sc0 = sc1 = sc2 = sc3 = sh0 = sh1 = sh2 = sh3 = make_float4(0.f, 0.f, 0.f, 0.f);
#pragma unroll 1
  for (int row = r_lo; row < r_hi; ++row) {
    const bool isctx = row >= TL;
    const int b = isctx ? 32 : (row >> 11);
    if (b != bcur) {
      bcur = b;
      const float* md = p.mod + (size_t)b * 3072;
      sh0 = *(const float4*)(md + c0); sh1 = *(const float4*)(md + c0 + 256); sh2 = *(const float4*)(md + c0 + 512); sh3 = *(const float4*)(md + c0 + 768);
      sc0 = *(const float4*)(md + 1024 + c0); sc1 = *(const float4*)(md + 1024 + c0 + 256); sc2 = *(const float4*)(md + 1024 + c0 + 512); sc3 = *(const float4*)(md + 1024 + c0 + 768);
    }
    const float* srcp = isctx ? (p.ctx + (size_t)(row - TL) * 1024) : (p.x + (size_t)row * 1024);
    mod0_row(srcp, p.u + (size_t)row * 1024, c0, sc0, sc1, sc2, sc3, sh0, sh1, sh2, sh3);
  }
}

namespace pg8 {
#define PG8_LAS __attribute__((address_space(3)))
constexpr int BM = 256, BK = 64, HALF = 128, HTB = HALF * BK * 2, STAGE_BYTES = 8 * HTB, NXCD = 8, WGM = 8;
DI int lds_byte(int r, int c) { const int st = (r >> 4) * 2 + (c >> 5), rr = r & 15, cc = c & 31, ob = rr * 64 + cc * 2; return st * 1024 + (ob ^ (((ob >> 9) & 1) << 5)); }
DI void stage_rc(int b, int& R, int& C) { const int st = b / 1024, sb = b % 1024, swz = sb ^ (((sb >> 9) & 1) << 5); R = (st >> 1) * 16 + swz / 64; C = (st & 1) * 32 + (swz % 64) / 2; }
DI int perm32(int rho) { const int n = rho >> 4, i = rho & 15; return 8 * (i >> 2) + 4 * n + (i & 3); }
struct Unit { int pm, pn; };
struct Gemm { const bf16_t* A; const bf16_t* Bt; int M, N, K, lda; };
struct StaticOrder {
  int nM, nN, nwg, G, c;
  DI void init(int M, int N, int G_, int c_) { nM = M / BM; nN = N / BM; nwg = nM * nN; G = G_; c = c_; }
  DI bool next(int i, Unit& u) const {
    const long L = (long)i * G + c; if (L >= nwg) return false;
    int wgid = (int)L; { const int q = nwg / NXCD, r = nwg % NXCD, xcd = wgid % NXCD, off = wgid / NXCD; wgid = (xcd < r ? xcd * (q + 1) : r * (q + 1) + (xcd - r) * q) + off; }
    const int nig = WGM * nN, gid = wgid / nig, fm = gid * WGM, gsz = (nM - fm) < WGM ? (nM - fm) : WGM;
    u.pm = fm + ((wgid % nig) % gsz); u.pn = (wgid % nig) / gsz; return true;
  }
};

template <class Epi>
DI void gemm_phase(PG8_LAS unsigned char* lds, const Gemm g, const StaticOrder& S, const Epi& E) {
  const int tid = opaque_tid(), wid = __builtin_amdgcn_readfirstlane(tid >> 6), lane = tid & 63, wr = wid >> 2, wc = wid & 3, fr = lane & 15, fq = lane >> 4;
  const int K = g.K, nt = K / BK, lda = g.lda;
  unsigned voffA[2], voffB[2];
#pragma unroll
  for (int i = 0; i < 2; ++i) { int R, C; stage_rc(tid * 16 + i * 8192, R, C); const int Rb = Epi::PERM ? ((R & ~31) + perm32(R & 31)) : R;
    voffA[i] = (unsigned)(R * lda + C) * 2u; voffB[i] = (unsigned)(Rb * K + C) * 2u; }
  const size_t kstep = (size_t)(BK * 2);
  const size_t hstepA = (size_t)HALF * lda * 2, hstepB = (size_t)HALF * K * 2;
  const size_t tstepA = 2 * hstepA, tstepB = 2 * hstepB;
  const unsigned ldsw = (unsigned)wid * 1024u;
  const int aoff = lds_byte(wr * 64 + fr, fq * 8), boff = lds_byte(wc * 32 + fr, fq * 8);
#define PG8_SA(b, h) (((b) * 2 + (h)) * HTB)
#define PG8_SB(b, h) ((4 + (b) * 2 + (h)) * HTB)
#define PG8_STAGE(bufoff, gbase, voff) do { _Pragma("unroll") for (int _i = 0; _i < 2; ++_i) \
    __builtin_amdgcn_global_load_lds((const unsigned*)((const char*)(gbase) + (voff)[_i]), (PG8_LAS unsigned*)(lds + (bufoff) + ldsw + _i * 8192), 16, 0, 0); } while (0)
#define PG8_LDA(dst, b, h) do { _Pragma("unroll") for (int m = 0; m < 4; ++m) _Pragma("unroll") for (int k = 0; k < 2; ++k) dst[m][k] = *(const PG8_LAS bf16x8*)(lds + PG8_SA(b, h) + aoff + m * 2048 + k * 1024); } while (0)
#define PG8_LDB(dst, b, h) do { _Pragma("unroll") for (int n = 0; n < 2; ++n) _Pragma("unroll") for (int k = 0; k < 2; ++k) dst[n][k] = *(const PG8_LAS bf16x8*)(lds + PG8_SB(b, h) + boff + n * 2048 + k * 1024); } while (0)
#define PG8_MMA(ai, bj, At, Bt) do { __builtin_amdgcn_s_setprio(1); _Pragma("unroll") for (int m = 0; m < 4; ++m) _Pragma("unroll") for (int n = 0; n < 2; ++n) _Pragma("unroll") for (int k = 0; k < 2; ++k) \
    acc[ai][bj][m][n] = __builtin_amdgcn_mfma_f32_16x16x32_bf16(Bt[n][k], At[m][k], acc[ai][bj][m][n], 0, 0, 0); __builtin_amdgcn_s_setprio(0); } while (0)
#define PG8_WAIT_V(n) asm volatile("s_waitcnt vmcnt(" #n ")" ::: "memory")
#define PG8_WAIT_L(n) asm volatile("s_waitcnt lgkmcnt(" #n ")" ::: "memory")
#define PG8_BAR __builtin_amdgcn_s_barrier()
#define PG8_SCHED __builtin_amdgcn_sched_barrier(0)
  Unit cur, nxt; int ui = 0;
  if (!S.next(0, cur)) return;
  f32x4 acc[2][2][4][2];
#pragma unroll
  for (int a = 0; a < 2; ++a)
#pragma unroll
    for (int b = 0; b < 2; ++b)
#pragma unroll
      for (int m = 0; m < 4; ++m)
#pragma unroll
        for (int n = 0; n < 2; ++n) acc[a][b][m][n] = (f32x4){0.f, 0.f, 0.f, 0.f};
  bf16x8 At[4][2], B0[2][2], B1[2][2];
  const char* cA = (const char*)g.A + (size_t)cur.pm * tstepA; const char* cB = (const char*)g.Bt + (size_t)cur.pn * tstepB;
  PG8_STAGE(PG8_SB(0, 0), cB, voffB); PG8_STAGE(PG8_SA(0, 0), cA, voffA); PG8_STAGE(PG8_SB(0, 1), cB + hstepB, voffB); PG8_STAGE(PG8_SA(0, 1), cA + hstepA, voffA);
  if (wr == 1) PG8_BAR;
  PG8_WAIT_V(4); PG8_BAR;
  PG8_STAGE(PG8_SB(1, 0), cB + kstep, voffB); PG8_STAGE(PG8_SA(1, 0), cA + kstep, voffA); PG8_STAGE(PG8_SB(1, 1), cB + hstepB + kstep, voffB);
  PG8_WAIT_V(6); PG8_BAR;
  for (;;) {
    const bool has_next = S.next(ui + 1, nxt);
    const char* nA = has_next ? (const char*)g.A + (size_t)nxt.pm * tstepA : cA; const char* nB = has_next ? (const char*)g.Bt + (size_t)nxt.pn * tstepB : cB;
    for (int t = 0; t < nt; t += 2) {
      const bool last = (t == nt - 2);
      const char* a1 = cA + (size_t)(t + 1) * kstep;
      const char* a2 = last ? nA : cA + (size_t)(t + 2) * kstep; const char* b2 = last ? nB : cB + (size_t)(t + 2) * kstep;
      const char* a3 = a2 + kstep; const char* b3 = b2 + kstep;
      PG8_LDB(B0, 0, 0); PG8_SCHED; PG8_LDA(At, 0, 0); PG8_STAGE(PG8_SA(1, 1), a1 + hstepA, voffA);
      PG8_WAIT_L(8); PG8_BAR; PG8_WAIT_L(0); PG8_MMA(0, 0, At, B0); PG8_BAR; PG8_SCHED;
      PG8_LDB(B1, 0, 1); PG8_STAGE(PG8_SB(0, 0), b2, voffB);
      PG8_BAR; PG8_WAIT_L(0); PG8_MMA(0, 1, At, B1); PG8_BAR;
      PG8_LDA(At, 0, 1); PG8_STAGE(PG8_SA(0, 0), a2, voffA);
      PG8_BAR; PG8_WAIT_L(0); PG8_MMA(1, 0, At, B0); PG8_BAR; PG8_SCHED;
      PG8_STAGE(PG8_SB(0, 1), b2 + hstepB, voffB);
      PG8_WAIT_V(6); PG8_BAR; PG8_MMA(1, 1, At, B1); PG8_BAR;
      PG8_LDB(B0, 1, 0); PG8_SCHED; PG8_LDA(At, 1, 0); PG8_STAGE(PG8_SA(0, 1), a2 + hstepA, voffA);
      PG8_WAIT_L(8); PG8_BAR; PG8_WAIT_L(0); PG8_MMA(0, 0, At, B0); PG8_BAR; PG8_SCHED;
      PG8_LDB(B1, 1, 1); PG8_STAGE(PG8_SB(1, 0), b3, voffB);
      PG8_BAR; PG8_WAIT_L(0); PG8_MMA(0, 1, At, B1); PG8_BAR;
      PG8_LDA(At, 1, 1); PG8_STAGE(PG8_SA(1, 0), a3, voffA);
      PG8_BAR; PG8_WAIT_L(0); PG8_MMA(1, 0, At, B0); PG8_BAR; PG8_SCHED;
      PG8_STAGE(PG8_SB(1, 1), b3 + hstepB, voffB);
      PG8_WAIT_V(6); PG8_BAR; PG8_MMA(1, 1, At, B1); PG8_BAR;
    }
    E(acc, cur, wr, wc, fr, fq);
    if (!has_next) break;
#pragma unroll
    for (int a = 0; a < 2; ++a)
#pragma unroll
      for (int b = 0; b < 2; ++b)
#pragma unroll
        for (int m = 0; m < 4; ++m)
#pragma unroll
          for (int n = 0; n < 2; ++n) acc[a][b][m][n] = (f32x4){0.f, 0.f, 0.f, 0.f};
    cur = nxt; cA = nA; cB = nB; ++ui;
  }
  PG8_WAIT_V(0);
  if (wr == 0) PG8_BAR;
  PG8_BAR;
#undef PG8_SA
#undef PG8_SB
#undef PG8_STAGE
#undef PG8_LDA
#undef PG8_LDB
#undef PG8_MMA
#undef PG8_WAIT_V
#undef PG8_WAIT_L
#undef PG8_BAR
#undef PG8_SCHED
}
}

template <int MODE>
struct EpiMk {
  static constexpr bool PERM = true;
  bf16_t* u; bf16_t* qkvg; LAS3 const float* rope;
  int pm_off, pn_off;
  DI void operator()(const f32x4 (&acc)[2][2][4][2], const pg8::Unit& un, int wr, int wc, int fr, int fq) const {
    constexpr bool isA = (MODE == 0);
    constexpr int NW = isA ? 2560 : 4096, kend = isA ? 1280 : 2048, vend = isA ? 1536 : 3072;
    const int upm = un.pm + pm_off, upn = un.pn + pn_off;
    const bool isctx = upm >= 256;
#pragma unroll
    for (int ai = 0; ai < 2; ++ai)
#pragma unroll
      for (int m = 0; m < 4; ++m) {
        const int row = upm * 256 + ai * 128 + wr * 64 + m * 16 + fr;
#pragma unroll
        for (int bj = 0; bj < 2; ++bj) {
          const int c128 = upn * 256 + bj * 128;
          const int col0 = c128 + wc * 32 + fq * 8;
          f32x4 v0 = acc[ai][bj][m][0], v1 = acc[ai][bj][m][1];
          if (MODE == 2) {
            u32x4 w; w[0] = pk2(v0[0], v0[1]); w[1] = pk2(v0[2], v0[3]); w[2] = pk2(v1[0], v1[1]); w[3] = pk2(v1[2], v1[3]);
            *(u32x4*)(u + (size_t)row * 1024 + col0) = w;
          } else {
            if (isA && !isctx && c128 < kend) {
              f32x4 p0, p1;
#pragma unroll
              for (int e = 0; e < 4; ++e) { p0[e] = __shfl_xor(v0[e], 32); p1[e] = __shfl_xor(v1[e], 32); }
              const int sp = row & 2047;
              const int pos = (wc & 1) ? (sp & 63) : (sp >> 6);
              LAS3 const float* tb = rope + (pos * 16 + 8 * (fq & 1)) * 2;
              const f32x4 t0 = *(LAS3 const f32x4*)(tb), t1 = *(LAS3 const f32x4*)(tb + 4), t2 = *(LAS3 const f32x4*)(tb + 8), t3 = *(LAS3 const f32x4*)(tb + 12);
              const float sg = (fq < 2) ? -1.f : 1.f;
              v0[0] = v0[0] * t0[0] + sg * p0[0] * t0[1]; v0[1] = v0[1] * t0[2] + sg * p0[1] * t0[3];
              v0[2] = v0[2] * t1[0] + sg * p0[2] * t1[1]; v0[3] = v0[3] * t1[2] + sg * p0[3] * t1[3];
              v1[0] = v1[0] * t2[0] + sg * p1[0] * t2[1]; v1[1] = v1[1] * t2[2] + sg * p1[1] * t2[3];
              v1[2] = v1[2] * t3[0] + sg * p1[2] * t3[1]; v1[3] = v1[3] * t3[2] + sg * p1[3] * t3[3];
            }
            if (c128 >= vend) {
#pragma unroll
              for (int e = 0; e < 4; ++e) { v0[e] = silu_f(v0[e]); v1[e] = silu_f(v1[e]); }
            } else if (c128 < 1024) {
              v0 = v0 * (0.125f * 1.4426950408889634f); v1 = v1 * (0.125f * 1.4426950408889634f);
            }
            u32x4 w; w[0] = pk2(v0[0], v0[1]); w[1] = pk2(v0[2], v0[3]); w[2] = pk2(v1[0], v1[1]); w[3] = pk2(v1[2], v1[3]);
            *(u32x4*)(qkvg + (size_t)row * NW + col0) = w;
          }
        }
      }
  }
};

template <int MODE>
DI void gemm_phase(const Params& p, const bf16_t* A, int lda, const bf16_t* Wt, int M, int N, char* smem, int pm_off = 0, int pn_off = 0) {
  pg8::Gemm g; g.A = A; g.Bt = Wt; g.M = M; g.N = N; g.K = 1024; g.lda = lda;
  pg8::StaticOrder S; S.init(M, N, (int)gridDim.x, (int)blockIdx.x);
  LAS3 float* ropel = (LAS3 float*)((LAS3 char*)smem + 131072);
  if (MODE == 0) {
    const int tid = opaque_tid();
    for (int e = tid; e < 64 * 16 * 2; e += NTHR) ropel[e] = p.rope[e];
    __syncthreads();
  }
  EpiMk<MODE> E{p.u, p.qkvg, ropel, pm_off, pn_off};
  pg8::gemm_phase(( PG8_LAS unsigned char*)smem, g, S, E);
  __syncthreads();
}
enum { EPI_A = 0, EPI_B = 1, EPI_OUT = 2 };

typedef short s16x4 __attribute__((ext_vector_type(4)));
constexpr int ATT_STAGE = 32768, ATT_NST = 3;
constexpr int ATT_GATE = ATT_NST * ATT_STAGE;
constexpr int ATT_TAB = ATT_GATE + 32768;
constexpr int TAB_NH = 4, TAB_HEAD0 = 32, TAB_HSTR = 480, TAB_NEG = 32 + TAB_NH * 480 + 64, TAB_FLOATS = TAB_NEG + 128;
constexpr float LOG2E = 1.4426950408889634f;
DI int crow(int v, int h) { return (v & 3) + 8 * (v >> 2) + 4 * h; }
DI int swz(int row) { return (((row >> 1) & 1) << 2) | ((row >> 2) & 3); }
DI bf16x8 tr_pair(LAS3 const char* plo, LAS3 const char* phi) {
  const s16x4 lo = __builtin_amdgcn_ds_read_tr16_b64_v4i16((LAS3 s16x4*)(plo));
  const s16x4 hi = __builtin_amdgcn_ds_read_tr16_b64_v4i16((LAS3 s16x4*)(phi));
  return __builtin_shufflevector(lo, hi, 0, 1, 2, 3, 4, 5, 6, 7);
}
struct AttnLane { int kr0, kr1, kr2, kr3, vr00, vr01, vr10, vr11; };
DI f32x16 qk_tile(LAS3 const char* kb, const AttnLane& L, const bf16x8& q0, const bf16x8& q1, const bf16x8& q2, const bf16x8& q3, const f32x16& init) {
  f32x16 s = __builtin_amdgcn_mfma_f32_32x32x16_bf16(*(LAS3 const bf16x8*)(kb + L.kr0), q0, init, 0, 0, 0);
  s = __builtin_amdgcn_mfma_f32_32x32x16_bf16(*(LAS3 const bf16x8*)(kb + L.kr1), q1, s, 0, 0, 0);
  s = __builtin_amdgcn_mfma_f32_32x32x16_bf16(*(LAS3 const bf16x8*)(kb + L.kr2), q2, s, 0, 0, 0);
  s = __builtin_amdgcn_mfma_f32_32x32x16_bf16(*(LAS3 const bf16x8*)(kb + L.kr3), q3, s, 0, 0, 0);
  return s;
}
DI void pv_tile(LAS3 const char* vb, const AttnLane& L, const f32x16& pr, f32x16& o0, f32x16& o1) {
  u32x4 w0, w1;
  w0[0] = pk2(pr[0], pr[1]); w0[1] = pk2(pr[2], pr[3]); w0[2] = pk2(pr[4], pr[5]); w0[3] = pk2(pr[6], pr[7]);
  w1[0] = pk2(pr[8], pr[9]); w1[1] = pk2(pr[10], pr[11]); w1[2] = pk2(pr[12], pr[13]); w1[3] = pk2(pr[14], pr[15]);
  const bf16x8 pf0 = __builtin_bit_cast(bf16x8, w0), pf1 = __builtin_bit_cast(bf16x8, w1);
  o0 = __builtin_amdgcn_mfma_f32_32x32x16_bf16(tr_pair(vb + L.vr00, vb + L.vr01), pf0, o0, 0, 0, 0);
  o1 = __builtin_amdgcn_mfma_f32_32x32x16_bf16(tr_pair(vb + L.vr10, vb + L.vr11), pf0, o1, 0, 0, 0);
  o0 = __builtin_amdgcn_mfma_f32_32x32x16_bf16(tr_pair(vb + 2048 + L.vr00, vb + 2048 + L.vr01), pf1, o0, 0, 0, 0);
  o1 = __builtin_amdgcn_mfma_f32_32x32x16_bf16(tr_pair(vb + 2048 + L.vr10, vb + 2048 + L.vr11), pf1, o1, 0, 0, 0);
}

struct AttnSt { f32x16 o0, o1, cinit; float m, l; };

template <int MK>
DI void attn_chunk(LAS3 const char* k0, LAS3 const char* k1, LAS3 const char* v0, LAS3 const char* v1, const AttnLane& L,
                   const bf16x8& q0, const bf16x8& q1, const bf16x8& q2, const bf16x8& q3,
                   AttnSt& st, const f32x16& init, const int h, const int kb0, const int kb1, const int sq, LAS3 const float* b0, LAS3 const float* b1) {
  f32x16 s0 = qk_tile(k0, L, q0, q1, q2, q3, init);
  f32x16 s1 = qk_tile(k1, L, q0, q1, q2, q3, init);
  if (MK == 2) {
#pragma unroll
    for (int v = 0; v < 16; ++v) { s0[v] += b0[(v & 3) + 8 * (v >> 2)]; s1[v] += b1[(v & 3) + 8 * (v >> 2)]; }
  }
  if (MK == 1 && kb1 != 0x7fffffff) {
    const int lo = max(0, sq - 128), hi = min(2047, sq + 128);
    const int L0 = lo - kb0 - 4 * h, H0 = hi - kb0 - 4 * h, L1 = lo - kb1 - 4 * h, H1 = hi - kb1 - 4 * h;
#pragma unroll
    for (int v = 0; v < 16; ++v) {
      const int cv = (v & 3) + 8 * (v >> 2);
      s0[v] = (cv >= L0 && cv <= H0) ? s0[v] : -1e30f;
      s1[v] = (cv >= L1 && cv <= H1) ? s1[v] : -1e30f;
    }
  }
#pragma unroll
  for (int v = 0; v < 16; ++v) s0[v] = __builtin_amdgcn_exp2f(s0[v]);
  const float a0 = (s0[0] + s0[1]) + (s0[2] + s0[3]), a1 = (s0[4] + s0[5]) + (s0[6] + s0[7]);
  const float a2 = (s0[8] + s0[9]) + (s0[10] + s0[11]), a3 = (s0[12] + s0[13]) + (s0[14] + s0[15]);
  pv_tile(v0, L, s0, st.o0, st.o1);
#pragma unroll
  for (int v = 0; v < 16; ++v) s1[v] = __builtin_amdgcn_exp2f(s1[v]);
  const float a4 = (s1[0] + s1[1]) + (s1[2] + s1[3]), a5 = (s1[4] + s1[5]) + (s1[6] + s1[7]);
  const float a6 = (s1[8] + s1[9]) + (s1[10] + s1[11]), a7 = (s1[12] + s1[13]) + (s1[14] + s1[15]);
  pv_tile(v1, L, s1, st.o0, st.o1);
  const float sum = ((a0 + a1) + (a2 + a3)) + ((a4 + a5) + (a6 + a7));
  st.l += sum;
  const float tot = sum + __shfl_xor(sum, 32);
  if (__builtin_amdgcn_ballot_w64(tot > 256.f) != 0) {
    const float delta = fmaxf(__builtin_amdgcn_logf(tot), 0.f);
    const float alpha = __builtin_amdgcn_exp2f(-delta);
    st.m += delta; st.l *= alpha;
#pragma unroll
    for (int v = 0; v < 16; ++v) { st.cinit[v] -= delta; st.o0[v] *= alpha; st.o1[v] *= alpha; }
  }
}

struct ItemD { int b, hk, nt, a0, a1; };
template <int MODE> DI ItemD item_desc(int item) {
  ItemD d; d.a0 = 0; d.a1 = 0;
  if (MODE == 0) { d.b = item >> 7; d.hk = (item >> 5) & 3; d.a0 = (item & 31) * 64 - 128; d.nt = 5; }
  else if (MODE == 1) {
    d.b = item >> 7; d.hk = (item >> 3) & 15; const int r0 = (item & 7) * 4;
    d.a0 = clampi(r0 - 4, 0, 24); d.a1 = clampi(r0 - 1, 0, 24) + 7; d.nt = 2 + ((d.a1 - d.a0 + 2) >> 1);
  } else if (MODE == 2) { d.b = item >> 4; d.hk = (item >> 2) & 3; d.nt = 2; }
  else { d.b = item >> 4; d.hk = item & 15; d.nt = 2; }
  return d;
}

template <int MODE>
DI void attn_seq(const Params& p, int layer, char* smem, const int tid, const int nitems, bf16_t* ob, const int ostride) {
  constexpr bool isA = (MODE == 0 || MODE == 2);
  constexpr bool isLat = (MODE < 2);
  constexpr int NW = isA ? 2560 : 4096, koff = 1024, voff = isA ? 1280 : 2048, goff = isA ? 1536 : 3072;
  const int jl = layer >> 1;
  const int lane = tid & 63, wv = __builtin_amdgcn_readfirstlane(tid >> 6), r = lane & 31, h = lane >> 5;
  const int item0 = (int)(((long)blockIdx.x * nitems) / (long)gridDim.x);
  const int nit = (int)(((long)(blockIdx.x + 1) * nitems) / (long)gridDim.x) - item0;
  if (nit <= 0) return;
  LAS3 char* lds = (LAS3 char*)smem;
  LAS3 const float* tab = (LAS3 const float*)(lds + ATT_TAB);
  const int hq_first = (MODE == 1) ? ((item0 >> 3) & 15) : 0;
  if (MODE == 1) {
    LAS3 float* tabw = (LAS3 float*)(lds + ATT_TAB);
    __syncthreads();
    for (int e = tid; e < TAB_FLOATS; e += NTHR) {
      float v = 0.f;
      const int t = e - TAB_HEAD0;
      if (t >= 0 && t < TAB_NH * TAB_HSTR) { const int hh = hq_first + t / TAB_HSTR, w = t % TAB_HSTR; if (w < 465 && hh < 16) v = p.b_rel_bias[((size_t)jl * 16 + hh) * 465 + w] * LOG2E; }
      if (e >= TAB_NEG) v = -1e30f;
      tabw[e] = v;
    }
  }
  const int cs_blk = (MODE == 1) ? clampi(16 * (wv & 3) - 8, 0, 32) : 0;
  auto make_lane = [&](const int cs) {
    AttnLane L;
    const int rr = r + cs, sw = swz(rr & 15);
    L.kr0 = rr * 128 + ((0 + h) ^ sw) * 16; L.kr1 = rr * 128 + ((2 + h) ^ sw) * 16; L.kr2 = rr * 128 + ((4 + h) ^ sw) * 16; L.kr3 = rr * 128 + ((6 + h) ^ sw) * 16;
    const int q = (lane & 15) >> 2, pp = lane & 3, g = (lane >> 4) & 1;
    const int ra = cs + 4 * h + q, rb = ra + 8;
    const int lp0 = 2 * g + (pp >> 1), lp1 = 4 + lp0;
    L.vr00 = ra * 128 + ((lp0 ^ swz(ra & 15)) * 16) + 8 * (pp & 1); L.vr01 = rb * 128 + ((lp0 ^ swz(rb & 15)) * 16) + 8 * (pp & 1);
    L.vr10 = ra * 128 + ((lp1 ^ swz(ra & 15)) * 16) + 8 * (pp & 1); L.vr11 = rb * 128 + ((lp1 ^ swz(rb & 15)) * 16) + 8 * (pp & 1);
    return L;
  };
  const int drow = 8 * wv + (lane >> 3);
  const int dlp = ((lane & 7) ^ swz(drow & 15)) * 8;
  auto issue = [&](const ItemD& d, int u, int stage) {
#pragma unroll
    for (int c = 0; c < 2; ++c) {
      int tok;
      if (u < 2) tok = TL + d.b * 256 + (2 * u + c) * 64 + drow;
      else if (MODE == 0) tok = d.b * 2048 + clampi(d.a0 + 64 * (2 * (u - 2) + c) + drow, 0, 2047);
      else tok = d.b * 2048 + min(d.a0 + 2 * (u - 2) + c, d.a1) * 64 + drow;
      const bf16_t* g = p.qkvg + (size_t)tok * NW + d.hk * 64 + dlp;
      __builtin_amdgcn_global_load_lds((const unsigned*)(g + koff), (LAS3 unsigned*)(lds + stage * ATT_STAGE + c * 8192 + wv * 1024), 16, 0, 0);
      __builtin_amdgcn_global_load_lds((const unsigned*)(g + voff), (LAS3 unsigned*)(lds + stage * ATT_STAGE + 16384 + c * 8192 + wv * 1024), 16, 0, 0);
    }
  };
  int gk = 0, gu = 0;
  ItemD gd = item_desc<MODE>(item0);
  int sa = 0;
  bool gvalid = true;
  auto gen_issue = [&]() {
    issue(gd, gu, sa);
    sa = (sa == ATT_NST - 1) ? 0 : sa + 1;
    if (++gu == gd.nt) { gu = 0; ++gk; if (gk < nit) gd = item_desc<MODE>(item0 + gk); else gvalid = false; }
  };
  __syncthreads();
  gen_issue();
  if (gvalid) gen_issue();
  int sc = 0, slast = 0;
#pragma unroll 1
  for (int k = 0; k < nit; ++k) {
    const int item = item0 + k;
    const ItemD d = item_desc<MODE>(item);
    int hq, tq, q0i = 0, rq = 0, cq = 0, wr_lo = 0, wr_hi = 0;
    if (MODE == 0) { hq = d.hk * 4 + (wv & 3); q0i = (item & 31) * 64 + 32 * (wv >> 2); tq = d.b * 2048 + q0i + r; }
    else if (MODE == 1) {
      hq = d.hk; const int rw = (item & 7) * 4 + 2 * (wv >> 2);
      rq = rw + (r >> 4); cq = 16 * (wv & 3) + (r & 15); tq = d.b * 2048 + rq * 64 + cq;
      wr_lo = clampi(rw - 4, 0, 24); wr_hi = clampi(rw - 3, 0, 24) + 7;
    } else if (MODE == 2) { hq = d.hk * 4 + (wv & 3); tq = TL + d.b * 256 + (item & 3) * 64 + 32 * (wv >> 2) + r; }
    else { hq = d.hk; tq = TL + d.b * 256 + wv * 32 + r; }
    {
#pragma unroll
      for (int pass = 0; pass < 4; ++pass) {
        const int row = (lane >> 3) + 8 * pass;
        int tqr;
        if (MODE == 0) tqr = d.b * 2048 + q0i + row;
        else if (MODE == 1) tqr = d.b * 2048 + ((item & 7) * 4 + 2 * (wv >> 2) + (row >> 4)) * 64 + 16 * (wv & 3) + (row & 15);
        else if (MODE == 2) tqr = TL + d.b * 256 + (item & 3) * 64 + 32 * (wv >> 2) + row;
        else tqr = TL + d.b * 256 + wv * 32 + row;
        __builtin_amdgcn_global_load_lds((const unsigned*)(p.qkvg + (size_t)tqr * NW + goff + hq * 64 + (lane & 7) * 8),
                                         (LAS3 unsigned*)(lds + ATT_GATE + wv * 4096 + pass * 1024), 16, 0, 0);
      }
    }
    const bf16_t* qp = p.qkvg + (size_t)tq * NW + hq * 64 + h * 8;
    const bf16x8 q0f = *(const bf16x8*)(qp), q1f = *(const bf16x8*)(qp + 16), q2f = *(const bf16x8*)(qp + 32), q3f = *(const bf16x8*)(qp + 48);
    AttnSt st;
#pragma unroll
    for (int v = 0; v < 16; ++v) {
      st.o0[v] = 0.f; st.o1[v] = 0.f;
      float ci = 0.f;
      if (MODE == 1) {
        const int cs_q = clampi(cq - 8, 0, 48);
        const int kc = cs_blk + crow(v, h);
        ci = (kc >= cs_q && kc < cs_q + 16) ? 0.f : -1e30f;
      }
      st.cinit[v] = ci;
    }
    st.m = 0.f; st.l = 0.f;
    const int colbase = cs_blk - cq + 15 + 4 * h;
#pragma unroll 1
    for (int u = 0; u < d.nt; ++u) {
      if (gvalid || !(k == nit - 1 && u == d.nt - 1)) asm volatile("s_waitcnt vmcnt(4)" ::: "memory");
      else asm volatile("s_waitcnt vmcnt(0)" ::: "memory");
      __builtin_amdgcn_s_barrier();
      asm volatile("" ::: "memory");
      if (gvalid) gen_issue();
      LAS3 const char* Kb = lds + sc * ATT_STAGE;
      LAS3 const char* Vb = Kb + 16384;
      slast = sc;
      sc = (sc == ATT_NST - 1) ? 0 : sc + 1;
      const AttnLane L = make_lane((MODE == 1 && u >= 2) ? cs_blk : 0);
      if (MODE == 0) {
#pragma unroll 1
        for (int c = 0; c < 2; ++c) {
          int kb0 = 0, kb1 = 0x7fffffff;
          if (u >= 2) {
            const int kbc = d.a0 + 64 * (2 * (u - 2) + c);
            if (kbc + 63 < 0 || kbc >= 2048 || kbc > q0i + 159 || kbc + 63 < q0i - 128) continue;
            const bool need_mask = (kbc < 0) || (kbc + 63 >= 2048) || (kbc < q0i + 31 - 128) || (kbc + 63 > q0i + 128);
            if (need_mask) { kb0 = kbc; kb1 = kbc + 32; }
          }
          attn_chunk<1>(Kb + c * 64 * 128, Kb + (c * 64 + 32) * 128, Vb + c * 64 * 128, Vb + (c * 64 + 32) * 128, L,
                        q0f, q1f, q2f, q3f, st, st.cinit, h, kb0, kb1, q0i + r, nullptr, nullptr);
        }
      } else if (!isLat || u < 2) {
#pragma unroll 1
        for (int c = 0; c < 2; ++c) {
          if (MODE == 1) {
            f32x16 cm;
#pragma unroll
            for (int v = 0; v < 16; ++v) cm[v] = -st.m;
            attn_chunk<0>(Kb + c * 64 * 128, Kb + (c * 64 + 32) * 128, Vb + c * 64 * 128, Vb + (c * 64 + 32) * 128, L,
                          q0f, q1f, q2f, q3f, st, cm, h, 0, 0, 0, nullptr, nullptr);
          } else {
            attn_chunk<0>(Kb + c * 64 * 128, Kb + (c * 64 + 32) * 128, Vb + c * 64 * 128, Vb + (c * 64 + 32) * 128, L,
                          q0f, q1f, q2f, q3f, st, st.cinit, h, 0, 0, 0, nullptr, nullptr);
          }
        }
      } else if (MODE == 1) {
        const int rrA = d.a0 + 2 * (u - 2), rrB = rrA + 1;
        const bool inA = (rrA >= wr_lo) && (rrA <= wr_hi), inB = (rrB >= wr_lo) && (rrB <= wr_hi) && (rrB <= d.a1);
        if (inA || inB) {
          const int rs_q = clampi(rq - 4, 0, 24);
          const bool okA = (rrA >= rs_q) && (rrA < rs_q + 8), okB = (rrB >= rs_q) && (rrB < rs_q + 8) && (rrB <= d.a1);
          LAS3 const float* bA = (okA ? (tab + TAB_HEAD0 + (hq - hq_first) * TAB_HSTR + (rrA - rq + 7) * 31) : (tab + TAB_NEG + 32)) + colbase;
          LAS3 const float* bB = (okB ? (tab + TAB_HEAD0 + (hq - hq_first) * TAB_HSTR + (rrB - rq + 7) * 31) : (tab + TAB_NEG + 32)) + colbase;
          attn_chunk<2>(Kb, Kb + 64 * 128, Vb, Vb + 64 * 128, L, q0f, q1f, q2f, q3f, st, st.cinit, h, 0, 0, 0, bA, bB);
        }
      }
    }
    float lsum = st.l + __shfl_xor(st.l, 32);
    if (isA) lsum += __builtin_amdgcn_exp2f(p.a_sink[jl * 16 + hq] * LOG2E - st.m);
    const float inv = 1.f / lsum;
    LAS3 char* scr = lds + ATT_GATE + wv * 4096;
    u32x4 gv0, gv1, gv2, gv3;
    gv0 = *(LAS3 const u32x4*)(scr + 0 * 1024 + lane * 16); gv1 = *(LAS3 const u32x4*)(scr + 1 * 1024 + lane * 16);
    gv2 = *(LAS3 const u32x4*)(scr + 2 * 1024 + lane * 16); gv3 = *(LAS3 const u32x4*)(scr + 3 * 1024 + lane * 16);
    asm volatile("s_waitcnt lgkmcnt(0)" ::: "memory");
    {
      const int swr = swz(r & 15);
#pragma unroll
      for (int g4 = 0; g4 < 4; ++g4) {
        u32x2 w0, w1;
        w0[0] = pk2(st.o0[4 * g4 + 0] * inv, st.o0[4 * g4 + 1] * inv); w0[1] = pk2(st.o0[4 * g4 + 2] * inv, st.o0[4 * g4 + 3] * inv);
        w1[0] = pk2(st.o1[4 * g4 + 0] * inv, st.o1[4 * g4 + 1] * inv); w1[1] = pk2(st.o1[4 * g4 + 2] * inv, st.o1[4 * g4 + 3] * inv);
        *(LAS3 u32x2*)(scr + r * 128 + ((g4 ^ swr) * 16) + 8 * h) = w0;
        *(LAS3 u32x2*)(scr + r * 128 + (((4 + g4) ^ swr) * 16) + 8 * h) = w1;
      }
    }
#pragma unroll
    for (int pass = 0; pass < 4; ++pass) {
      const int row = (lane >> 3) + 8 * pass, piece = lane & 7;
      const u32x4 ov = *(LAS3 const u32x4*)(scr + row * 128 + ((piece ^ swz(row & 15)) * 16));
      int tqr;
      if (MODE == 0) tqr = d.b * 2048 + q0i + row;
      else if (MODE == 1) tqr = d.b * 2048 + ((item & 7) * 4 + 2 * (wv >> 2) + (row >> 4)) * 64 + 16 * (wv & 3) + (row & 15);
      else if (MODE == 2) tqr = TL + d.b * 256 + (item & 3) * 64 + 32 * (wv >> 2) + row;
      else tqr = TL + d.b * 256 + wv * 32 + row;
      const u32x4 gv = (pass == 0) ? gv0 : (pass == 1) ? gv1 : (pass == 2) ? gv2 : gv3;
      uint4 w;
      w.x = pk2(bflo(ov[0]) * bflo(gv[0]), bfhi(ov[0]) * bfhi(gv[0]));
      w.y = pk2(bflo(ov[1]) * bflo(gv[1]), bfhi(ov[1]) * bfhi(gv[1]));
      w.z = pk2(bflo(ov[2]) * bflo(gv[2]), bfhi(ov[2]) * bfhi(gv[2]));
      w.w = pk2(bflo(ov[3]) * bflo(gv[3]), bfhi(ov[3]) * bfhi(gv[3]));
      *(uint4*)(ob + (size_t)tqr * ostride + hq * 64 + piece * 8) = w;
    }
    asm volatile("s_waitcnt lgkmcnt(0)" ::: "memory");
  }
}

DI void attn_phase(const Params& p, int layer, char* smem, bf16_t* ob, const int ostride) {
  const bool isA = !(layer & 1);
  const bool ctx_out = layer < 3;
  if (isA) {
    { const int tid = opaque_tid(); attn_seq<0>(p, layer, smem, tid, 4096, ob, ostride); }
    if (ctx_out) { const int tid = opaque_tid(); attn_seq<2>(p, layer, smem, tid, 512, ob, ostride); }
  } else {
    { const int tid = opaque_tid(); attn_seq<1>(p, layer, smem, tid, 4096, ob, ostride); }
    if (ctx_out) { const int tid = opaque_tid(); attn_seq<3>(p, layer, smem, tid, 512, ob, ostride); }
  }
  __syncthreads();
}

#define XB_TMO      128
#define XB_XCNT(j)  (256  + 64 * (j))
#define XB_XSUB(j)  (1280 + 64 * (j))
#define XB_XGEN(j)  (2304 + 64 * (j))
#define XB_TOP      3328
#define XB_TOPGEN   3392
#define XCD_BAR_WORDS 3456
#define XB_SPIN_CAP (1u << 18)
DI unsigned xb_ld(unsigned* p)              { return __hip_atomic_load(p, __ATOMIC_RELAXED, __HIP_MEMORY_SCOPE_AGENT); }
DI unsigned xb_add(unsigned* p, unsigned v) { return __hip_atomic_fetch_add(p, v, __ATOMIC_RELAXED, __HIP_MEMORY_SCOPE_AGENT); }
DI unsigned xb_xcc_id() { return (unsigned)__builtin_amdgcn_s_getreg((3 << 11) | 20) & 0xFu; }
#define XB_SPIN(cond, bar) do { unsigned _sp = 0; while (cond) { __builtin_amdgcn_s_sleep(1); \
    if ((++_sp & 255u) == 0u) { if (xb_ld(&(bar)[XB_TMO])) break; if (_sp > XB_SPIN_CAP) { atomicAdd(&(bar)[XB_TMO], 1u); break; } } } } while (0)
DI void xcd_barrier_post(unsigned* bar) { if (threadIdx.x == 0) (void)xb_add(&bar[XB_XCNT(xb_xcc_id())], 1u); }
DI void xcd_barrier_complete(unsigned* bar, unsigned x, unsigned& nloc, unsigned& nx) {
  const unsigned G = gridDim.x;
  unsigned sum, cnt, mine, sp = 0u;
  for (;;) {
    sum = 0u; cnt = 0u; mine = 0u;
#pragma unroll
    for (unsigned j = 0; j < 16; ++j) { const unsigned c = xb_ld(&bar[XB_XCNT(j)]); sum += c; cnt += (c > 0u) ? 1u : 0u; mine = (j == x) ? c : mine; }
    if (sum == G) break;
    __builtin_amdgcn_s_sleep(1);
    if ((++sp & 255u) == 0u) { if (xb_ld(&bar[XB_TMO])) break; if (sp > XB_SPIN_CAP) { atomicAdd(&bar[XB_TMO], 1u); break; } }
  }
  nloc = mine > 0u ? mine : 1u; nx = cnt > 0u ? cnt : 1u;
}
DI void xcd_barrier(unsigned* bar, volatile LAS3 unsigned* st) {
  asm volatile("s_waitcnt vmcnt(0)" ::: "memory");
  __syncthreads();
  if (threadIdx.x == 0) {
    const unsigned x = xb_xcc_id();
    __builtin_amdgcn_s_waitcnt(0);
    unsigned nloc = st[0], nx = st[1];
    if (nloc == 0u) { xcd_barrier_complete(bar, x, nloc, nx); st[0] = nloc; st[1] = nx; }
    const unsigned old = xb_add(&bar[XB_XSUB(x)], 1u);
    const unsigned gen = old / nloc;
    if (old + 1u == (gen + 1u) * nloc) {
      __builtin_amdgcn_fence(__ATOMIC_RELEASE, "agent");
      asm volatile("s_waitcnt vmcnt(0)" ::: "memory");
      const unsigned og = xb_add(&bar[XB_TOP], 1u);
      const unsigned tg = og / nx;
      if (og + 1u == (tg + 1u) * nx) xb_add(&bar[XB_TOPGEN], 1u);
      else XB_SPIN(xb_ld(&bar[XB_TOPGEN]) == tg, bar);
      __builtin_amdgcn_fence(__ATOMIC_ACQUIRE, "agent");
      xb_add(&bar[XB_XGEN(x)], 1u);
      asm volatile("s_waitcnt vmcnt(0)" ::: "memory");
    } else {
      XB_SPIN(xb_ld(&bar[XB_XGEN(x)]) == gen, bar);
      __builtin_amdgcn_fence(__ATOMIC_ACQUIRE, "agent");
      asm volatile("s_waitcnt vmcnt(0)" ::: "memory");
    }
  }
  __syncthreads();
}

typedef _Float16 h16x2 __attribute__((ext_vector_type(2)));
DI unsigned pkh2(float lo, float hi) { f32x2 v = {lo, hi}; return __builtin_bit_cast(unsigned, __builtin_convertvector(v, h16x2)); }
DI float hlo(unsigned u) { return (float)__builtin_bit_cast(h16x2, u)[0]; }
DI float hhi(unsigned u) { return (float)__builtin_bit_cast(h16x2, u)[1]; }
struct LnVec { float4 a, b, c, d; };
DI LnVec ln_ldvec(const float* v, int c0) { LnVec r; r.a = *(const float4*)(v + c0); r.b = *(const float4*)(v + c0 + 4); r.c = *(const float4*)(v + 512 + c0); r.d = *(const float4*)(v + 512 + c0 + 4); return r; }
DI float4 ld_nt4(const float* p) { const f32x4 v = __builtin_nontemporal_load((const f32x4*)p); return make_float4(v[0], v[1], v[2], v[3]); }
DI float4 h4lo(const u32x4 v) { return make_float4(hlo(v[0]), hhi(v[0]), hlo(v[1]), hhi(v[1])); }
DI float4 h4hi(const u32x4 v) { return make_float4(hlo(v[2]), hhi(v[2]), hlo(v[3]), hhi(v[3])); }
DI float4 b4lo(const uint4 v) { return make_float4(bflo(v.x), bfhi(v.x), bflo(v.y), bfhi(v.y)); }
DI float4 b4hi(const uint4 v) { return make_float4(bflo(v.z), bfhi(v.z), bflo(v.w), bfhi(v.w)); }
DI float4 zmix(const float4 h, const float4 g, const float4 y) { return make_float4(ALPHA * h.x + g.x * y.x, ALPHA * h.y + g.y * y.y, ALPHA * h.z + g.z * y.z, ALPHA * h.w + g.w * y.w); }
DI float sq4(float4 z, float mean) {
  float a = z.x - mean, b = z.y - mean, c = z.z - mean, d = z.w - mean;
  return a * a + b * b + c * c + d * d;
}
struct LnRow { float4 z0, z1, z2, z3; };
template <bool IN16>
DI LnRow ln_load(const float* hin, const unsigned short* hin16, const bf16_t* yu, const LnVec& gate, int c0) {
  LnRow r;
  const uint4 ya = *(const uint4*)(yu + c0), yb = *(const uint4*)(yu + 512 + c0);
  float4 h0, h1, h2, h3;
  if (IN16) {
    const u32x4 ha = __builtin_nontemporal_load((const u32x4*)(hin16 + c0)), hb = __builtin_nontemporal_load((const u32x4*)(hin16 + 512 + c0));
    h0 = h4lo(ha); h1 = h4hi(ha); h2 = h4lo(hb); h3 = h4hi(hb);
  } else {
    h0 = ld_nt4(hin + c0); h1 = ld_nt4(hin + c0 + 4); h2 = ld_nt4(hin + 512 + c0); h3 = ld_nt4(hin + 512 + c0 + 4);
  }
  r.z0 = zmix(h0, gate.a, b4lo(ya)); r.z1 = zmix(h1, gate.b, b4hi(ya)); r.z2 = zmix(h2, gate.c, b4lo(yb)); r.z3 = zmix(h3, gate.d, b4hi(yb));
  return r;
}
DI float4 ln_norm(const float4 z, float mean, float rstd, const float4 g, const float4 b) {
  return make_float4((z.x - mean) * rstd * g.x + b.x, (z.y - mean) * rstd * g.y + b.y, (z.z - mean) * rstd * g.z + b.z, (z.w - mean) * rstd * g.w + b.w);
}
DI unsigned umod(float a, float b, float sca, float scb, float sha, float shb) { return pk2(a * (1.f + sca) + sha, b * (1.f + scb) + shb); }
template <bool OUT16>
DI void ln_finish(const LnRow& r, float* hout, unsigned short* hout16, bf16_t* yu, const LnVec& g, const LnVec& b, const LnVec& sc, const LnVec& sh, int c0, bool wr_u) {
  const float sum = (r.z0.x + r.z0.y + r.z0.z + r.z0.w) + (r.z1.x + r.z1.y + r.z1.z + r.z1.w) + (r.z2.x + r.z2.y + r.z2.z + r.z2.w) + (r.z3.x + r.z3.y + r.z3.z + r.z3.w);
  const float mean = wave_sum(sum) * (1.f / 1024.f);
  const float sq = sq4(r.z0, mean) + sq4(r.z1, mean) + sq4(r.z2, mean) + sq4(r.z3, mean);
  const float rstd = rsqrtf(wave_sum(sq) * (1.f / 1024.f) + 1e-5f);
  const float4 o0 = ln_norm(r.z0, mean, rstd, g.a, b.a), o1 = ln_norm(r.z1, mean, rstd, g.b, b.b), o2 = ln_norm(r.z2, mean, rstd, g.c, b.c), o3 = ln_norm(r.z3, mean, rstd, g.d, b.d);
  if (OUT16) {
    u32x4 wa, wb;
    wa[0] = pkh2(o0.x, o0.y); wa[1] = pkh2(o0.z, o0.w); wa[2] = pkh2(o1.x, o1.y); wa[3] = pkh2(o1.z, o1.w);
    wb[0] = pkh2(o2.x, o2.y); wb[1] = pkh2(o2.z, o2.w); wb[2] = pkh2(o3.x, o3.y); wb[3] = pkh2(o3.z, o3.w);
    __builtin_nontemporal_store(wa, (u32x4*)(hout16 + c0));
    __builtin_nontemporal_store(wb, (u32x4*)(hout16 + 512 + c0));
  } else {
    f32x4 v;
    v[0] = o0.x; v[1] = o0.y; v[2] = o0.z; v[3] = o0.w; __builtin_nontemporal_store(v, (f32x4*)(hout + c0));
    v[0] = o1.x; v[1] = o1.y; v[2] = o1.z; v[3] = o1.w; __builtin_nontemporal_store(v, (f32x4*)(hout + c0 + 4));
    v[0] = o2.x; v[1] = o2.y; v[2] = o2.z; v[3] = o2.w; __builtin_nontemporal_store(v, (f32x4*)(hout + 512 + c0));
    v[0] = o3.x; v[1] = o3.y; v[2] = o3.z; v[3] = o3.w; __builtin_nontemporal_store(v, (f32x4*)(hout + 512 + c0 + 4));
  }
  if (wr_u) {
    uint4 ua, ub;
    ua.x = umod(o0.x, o0.y, sc.a.x, sc.a.y, sh.a.x, sh.a.y); ua.y = umod(o0.z, o0.w, sc.a.z, sc.a.w, sh.a.z, sh.a.w);
    ua.z = umod(o1.x, o1.y, sc.b.x, sc.b.y, sh.b.x, sh.b.y); ua.w = umod(o1.z, o1.w, sc.b.z, sc.b.w, sh.b.z, sh.b.w);
    ub.x = umod(o2.x, o2.y, sc.c.x, sc.c.y, sh.c.x, sh.c.y); ub.y = umod(o2.z, o2.w, sc.c.z, sc.c.w, sh.c.z, sh.c.w);
    ub.z = umod(o3.x, o3.y, sc.d.x, sc.d.y, sh.d.x, sh.d.y); ub.w = umod(o3.z, o3.w, sc.d.z, sc.d.w, sh.d.z, sh.d.w);
    *(uint4*)(yu + c0) = ua;
    *(uint4*)(yu + 512 + c0) = ub;
  }
}
template <bool IN16, bool OUT16>
DI void ln_body(const Params& p, int layer) {
  const int tid = opaque_tid(), lane = tid & 63, wave = __builtin_amdgcn_readfirstlane(tid >> 6);
  const int nrows = (layer < 3) ? TT : TL;
  const bool wr_u = layer < 3;
  const int c0 = lane * 8;
  const float* lgp = p.ln_g + layer * 1024;
  const float* lbp = p.ln_b + layer * 1024;
  const int nw = gridDim.x * 8, gw = blockIdx.x * 8 + wave;
  const int r_lo = (int)(((long)gw * nrows) / nw), r_hi = (int)(((long)(gw + 1) * nrows) / nw);
  constexpr bool in16 = IN16, out16 = OUT16;
  int bcur = -1;
  LnVec gate = ln_ldvec(lgp, c0);
  const float* md2 = p.mod;
#pragma unroll 1
  for (int row = r_lo; row < r_hi; row += 4) {
    const int nr = min(4, r_hi - row);
    const int bq = (row >= TL) ? 32 : (row >> 11);
    const int bl = (row + nr - 1 >= TL) ? 32 : ((row + nr - 1) >> 11);
    if (bq != bl || nr < 4) {
      for (int j = 0; j < nr; ++j) {
        const int rj = row + j;
        const bool isctx = rj >= TL;
        const int b = isctx ? 32 : (rj >> 11);
        if (b != bcur) {
          bcur = b;
          const float* md = p.mod + ((size_t)layer * 33 + b) * 3072;
          md2 = p.mod + ((size_t)(wr_u ? layer + 1 : layer) * 33 + b) * 3072;
          gate = ln_ldvec(md + 2048, c0);
        }
        const float* hin = isctx ? (p.ctx + (size_t)(rj - TL) * 1024) : (p.x + (size_t)rj * 1024);
        const unsigned short* hin16 = in16 ? (p.h16 + (size_t)rj * 1024) : nullptr;
        float* hout = p.out + (size_t)(isctx ? 0 : rj) * 1024;
        unsigned short* hout16 = out16 ? (p.h16 + (size_t)rj * 1024) : nullptr;
        bf16_t* yu = p.u + (size_t)rj * 1024;
        const LnRow ra = ln_load<IN16>(hin, hin16, yu, gate, c0);
        const LnVec g = ln_ldvec(lgp, c0), bb = ln_ldvec(lbp, c0), sc = ln_ldvec(md2 + 1024, c0), sh = ln_ldvec(md2, c0);
        ln_finish<OUT16>(ra, hout, hout16, yu, g, bb, sc, sh, c0, wr_u);
      }
      continue;
    }
    if (bq != bcur) {
      bcur = bq;
      const float* md = p.mod + ((size_t)layer * 33 + bq) * 3072;
      md2 = p.mod + ((size_t)(wr_u ? layer + 1 : layer) * 33 + bq) * 3072;
      gate = ln_ldvec(md + 2048, c0);
    }
    const bool isctx = row >= TL;
    const float* hin = isctx ? (p.ctx + (size_t)(row - TL) * 1024) : (p.x + (size_t)row * 1024);
    const unsigned short* hin16 = in16 ? (p.h16 + (size_t)row * 1024) : nullptr;
    float* hout = p.out + (size_t)(isctx ? 0 : row) * 1024;
    unsigned short* hout16 = out16 ? (p.h16 + (size_t)row * 1024) : nullptr;
    bf16_t* yu = p.u + (size_t)row * 1024;
    const unsigned short* hb = hin16 ? hin16 + 1024 : nullptr; const unsigned short* hc_ = hin16 ? hin16 + 2048 : nullptr; const unsigned short* hd = hin16 ? hin16 + 3072 : nullptr;
    const LnRow ra = ln_load<IN16>(hin, hin16, yu, gate, c0), rb = ln_load<IN16>(hin + 1024, hb, yu + 1024, gate, c0), rc = ln_load<IN16>(hin + 2048, hc_, yu + 2048, gate, c0), rd = ln_load<IN16>(hin + 3072, hd, yu + 3072, gate, c0);
    const LnVec g = ln_ldvec(lgp, c0), bb = ln_ldvec(lbp, c0), sc = ln_ldvec(md2 + 1024, c0), sh = ln_ldvec(md2, c0);
    ln_finish<OUT16>(ra, hout, hout16, yu, g, bb, sc, sh, c0, wr_u);
    ln_finish<OUT16>(rb, hout + 1024, hout16 ? hout16 + 1024 : nullptr, yu + 1024, g, bb, sc, sh, c0, wr_u);
    ln_finish<OUT16>(rc, hout + 2048, hout16 ? hout16 + 2048 : nullptr, yu + 2048, g, bb, sc, sh, c0, wr_u);
    ln_finish<OUT16>(rd, hout + 3072, hout16 ? hout16 + 3072 : nullptr, yu + 3072, g, bb, sc, sh, c0, wr_u);
  }
}

DI void ln_phase(const Params& p, int layer) {
  if (layer == 0) ln_body<false, true>(p, layer);
  else if (layer < 3) ln_body<true, true>(p, layer);
  else ln_body<true, false>(p, layer);
}

__global__ void __launch_bounds__(512, 2) mega(Params p, int ph_lo, int ph_hi) {
  extern __shared__ __attribute__((aligned(16))) char smem[];
  volatile LAS3 unsigned* bst = (volatile LAS3 unsigned*)(smem + SMEM_BAR);
  if (ph_hi - ph_lo > 1) {
    if (threadIdx.x == 0) { bst[0] = 0u; bst[1] = 0u; }
    __syncthreads();
    xcd_barrier_post(p.bar);
  }
  for (int ph = ph_lo; ph < ph_hi; ++ph) {
    if (ph == 0) phase_prep(p, (float*)smem);
    else if (ph == 1) phase_mod0(p);
    else {
      const int layer = (ph - 2) >> 2, sub = (ph - 2) & 3;
      const bool isA = !(layer & 1);
      const int jl = layer >> 1;
      const int NW = isA ? 2560 : 4096;
      if (sub == 0) {
        if (isA) gemm_phase<EPI_A>(p, p.u, 1024, p.wt_a_in + (size_t)jl * 2560 * 1024, TT, 2560, smem);
        else if (layer < 3) gemm_phase<EPI_B>(p, p.u, 1024, p.wt_b_in + (size_t)jl * 4096 * 1024, TT, 4096, smem);
        else {
          gemm_phase<EPI_B>(p, p.u, 1024, p.wt_b_in + (size_t)jl * 4096 * 1024, TL, 4096, smem);
          gemm_phase<EPI_B>(p, p.u + (size_t)TL * 1024, 1024, p.wt_b_in + (size_t)jl * 4096 * 1024 + (size_t)1024 * 1024, TC, 2048, smem, 256, 4);
        }
      } else if (sub == 1) {
        attn_phase(p, layer, smem, p.qkvg + (isA ? 1536 : 3072), NW);
      } else if (sub == 2) {
        const int M = (layer < 3) ? TT : TL;
        const int goff = isA ? 1536 : 3072;
        gemm_phase<EPI_OUT>(p, p.qkvg + goff, NW, (isA ? p.wt_a_out : p.wt_b_out) + (size_t)jl * 1024 * 1024, M, 1024, smem);
      } else {
        ln_phase(p, layer);
      }
    }
    if (ph + 1 < ph_hi) { if (ph_hi > 1000) cg::this_grid().sync(); else xcd_barrier(p.bar, bst); }
  }
}

extern "C" void kernel_launch(void* const* d_in, const int* in_sizes, int n_in, void* d_out, int out_size, void* d_ws, size_t ws_size,
                              hipStream_t stream) {
  static int grid_blocks = 0;
  if (!grid_blocks) {
    int dev = 0, cus = 0, per_cu = 0;
    (void)hipGetDevice(&dev);
    (void)hipDeviceGetAttribute(&cus, hipDeviceAttributeMultiprocessorCount, dev);
    (void)hipFuncSetAttribute((const void*)mega, hipFuncAttributeMaxDynamicSharedMemorySize, SMEM_BYTES);
    (void)hipOccupancyMaxActiveBlocksPerMultiprocessor(&per_cu, mega, NTHR, SMEM_BYTES);
    if (per_cu < 1) per_cu = 1;
    grid_blocks = cus * per_cu;
  }
  Params p{};
  p.x = (const float*)d_in[0]; p.c = (const float*)d_in[1]; p.ctx = (const float*)d_in[2]; p.c_ctx = (const float*)d_in[3];
  p.w_ada = (const float*)d_in[4]; p.b_ada = (const float*)d_in[5]; p.ln_g = (const float*)d_in[6]; p.ln_b = (const float*)d_in[7];
  p.a_w_in = (const float*)d_in[8]; p.a_w_out = (const float*)d_in[9]; p.a_sink = (const float*)d_in[10];
  p.b_w_in = (const float*)d_in[11]; p.b_w_out = (const float*)d_in[12]; p.b_rel_bias = (const float*)d_in[13];
  p.out = (float*)d_out;
  char* w = (char*)d_ws;
  size_t off = 0;
  auto take = [&](size_t bytes) { char* r = w + off; off += (bytes + 255) & ~(size_t)255; return r; };
  p.hc = (float*)take((size_t)TC * 1024 * 4);
  p.u = (bf16_t*)take((size_t)TT * 1024 * 2);
  p.qkvg = (bf16_t*)take((size_t)TT * 4096 * 2);
  p.h16 = (unsigned short*)take((size_t)TT * 1024 * 2);
  p.wt_a_in = (bf16_t*)take((size_t)2 * 2560 * 1024 * 2);
  p.wt_a_out = (bf16_t*)take((size_t)2 * 1024 * 1024 * 2);
  p.wt_b_in = (bf16_t*)take((size_t)2 * 4096 * 1024 * 2);
  p.wt_b_out = (bf16_t*)take((size_t)2 * 1024 * 1024 * 2);
  p.mod = (float*)take((size_t)5 * 33 * 3072 * 4);
  p.rope = (float*)take((size_t)64 * 16 * 2 * 4);
  p.bar = (unsigned*)take((size_t)XCD_BAR_WORDS * 4);
  if (off > ws_size) { fprintf(stderr, "workspace too small: need %zu have %zu\n", off, ws_size); return; }
#if MK_COOP
  (void)hipMemsetAsync(p.bar, 0, (size_t)XCD_BAR_WORDS * 4, stream);
  int lo = 0, hi = NPHASE;
  void* args[] = {&p, &lo, &hi};
  hipError_t e = hipLaunchCooperativeKernel((void*)mega, dim3(grid_blocks), dim3(NTHR), args, SMEM_BYTES, stream);
  if (e != hipSuccess) fprintf(stderr, "cooperative launch failed: %s (grid %d)\n", hipGetErrorString(e), grid_blocks);
#else
  for (int ph = 0; ph < NPHASE; ++ph) hipLaunchKernelGGL(mega, dim3(grid_blocks), dim3(NTHR), SMEM_BYTES, stream, p, ph, ph + 1);
#endif
}
```

```cpp
#include <hip/hip_runtime.h>
#include <hip/hip_cooperative_groups.h>
#include <cstdio>
namespace cg = cooperative_groups;

#ifndef MK_COOP
#define MK_COOP 1
#endif

typedef unsigned short bf16_t;
typedef short bf16x8 __attribute__((ext_vector_type(8)));
typedef float f32x16 __attribute__((ext_vector_type(16)));
typedef float f32x2 __attribute__((ext_vector_type(2)));
typedef __bf16 bf16x2v __attribute__((ext_vector_type(2)));
typedef float f32x4 __attribute__((ext_vector_type(4)));
typedef unsigned u32x4 __attribute__((ext_vector_type(4)));
typedef unsigned u32x2 __attribute__((ext_vector_type(2)));

#define DI __device__ __forceinline__
#define LAS3 __attribute__((address_space(3)))

constexpr int NB = 32, SEQ = 2048, DM = 1024, CTXL = 256;
constexpr int TL = NB * SEQ;
constexpr int TC = NB * CTXL;
constexpr int TT = TL + TC;
constexpr int NPHASE = 18;
constexpr float ALPHA = 1.681792830507429f;
constexpr int SMEM_BYTES = 98304 + 32768 + 8704 + 16;
constexpr int SMEM_BAR = 98304 + 32768 + 8704;
constexpr int NTHR = 512;

DI unsigned pk2(float lo, float hi) { f32x2 v = {lo, hi}; return __builtin_bit_cast(unsigned, __builtin_convertvector(v, bf16x2v)); }
DI float bf2f(bf16_t x) { return __uint_as_float(((unsigned)x) << 16); }
DI float bflo(unsigned u) { return __uint_as_float(u << 16); }
DI float bfhi(unsigned u) { return __uint_as_float(u & 0xffff0000u); }
DI float silu_f(float x) { return x * __builtin_amdgcn_rcpf(1.f + __expf(-x)); }
DI float wave_sum(float v) {
#pragma unroll
  for (int o = 32; o > 0; o >>= 1) v += __shfl_xor(v, o);
  return v;
}
DI float wave_max(float v) {
#pragma unroll
  for (int o = 32; o > 0; o >>= 1) v = fmaxf(v, __shfl_xor(v, o));
  return v;
}
DI int opaque_tid() { int t = threadIdx.x; asm volatile("" : "+v"(t)); return t; }
DI int clampi(int x, int lo, int hi) { return x < lo ? lo : (x > hi ? hi : x); }

struct Params {
  const float *x, *c, *ctx, *c_ctx, *w_ada, *b_ada, *ln_g, *ln_b, *a_w_in, *a_w_out, *a_sink, *b_w_in, *b_w_out, *b_rel_bias;
  float* out;
  float* hc;
  bf16_t* u;
  bf16_t* qkvg;
  unsigned short* h16;
  bf16_t* wt_a_in;
  bf16_t* wt_a_out;
  bf16_t* wt_b_in;
  bf16_t* wt_b_out;
  float* mod;
  float* rope;
  unsigned* bar;
};

DI void prep_mod_item(const Params& p, int item, float* smem) {
  const int tid = opaque_tid(), lane = tid & 63, wv = tid >> 6;
  const int layer = item / 48, cgp = item % 48;
  const int col = cgp * 64 + lane;
  float acc[33];
#pragma unroll
  for (int b = 0; b < 33; ++b) acc[b] = 0.f;
  const float* W = p.w_ada + (size_t)layer * 1024 * 3072;
#pragma unroll 1
  for (int half = 0; half < 2; ++half) {
    __syncthreads();
    for (int e = tid; e < 33 * 512; e += NTHR) {
      const int kk = e & 511, b = e >> 9;
      const int k = half * 512 + kk;
      const float v = (b < 32) ? p.c[b * 1024 + k] : p.c_ctx[k];
      smem[e] = silu_f(v);
    }
    __syncthreads();
    const float* Wh = W + (size_t)(half * 512 + wv * 64) * 3072 + col;
    const float* sg = smem + wv * 64;
#pragma unroll 8
    for (int kk = 0; kk < 64; ++kk) {
      const float w = Wh[(size_t)kk * 3072];
#pragma unroll
      for (int b = 0; b < 33; ++b) acc[b] += sg[b * 512 + kk] * w;
    }
  }
  __syncthreads();
#pragma unroll
  for (int b = 0; b < 33; ++b) smem[(wv * 33 + b) * 64 + lane] = acc[b];
  __syncthreads();
  for (int e = tid; e < 33 * 64; e += NTHR) {
    const int l = e & 63, b = e >> 6;
    float s = 0.f;
#pragma unroll
    for (int w = 0; w < 8; ++w) s += smem[(w * 33 + b) * 64 + l];
    const int cc = cgp * 64 + l;
    p.mod[((size_t)layer * 33 + b) * 3072 + cc] = s + p.b_ada[layer * 3072 + cc];
  }
  __syncthreads();
}

DI void prep_transpose_item(const float* W, bf16_t* Wt, int N, int kt, int ng, float* smem) {
  const int tid = opaque_tid();
  __syncthreads();
#pragma unroll
  for (int t = 0; t < 4; ++t)
#pragma unroll
    for (int i = 0; i < 8; ++i) {
      const int kl = i * 8 + (tid >> 6), nl = tid & 63;
      smem[t * (64 * 65) + kl * 65 + nl] = W[(size_t)(kt * 64 + kl) * N + ng * 256 + t * 64 + nl];
    }
  __syncthreads();
#pragma unroll
  for (int t = 0; t < 4; ++t)
#pragma unroll
    for (int i = 0; i < 8; ++i) {
      const int nl = i * 8 + (tid >> 6), kl = tid & 63;
      const float v = smem[t * (64 * 65) + kl * 65 + nl];
      Wt[(size_t)(ng * 256 + t * 64 + nl) * 1024 + kt * 64 + kl] = (bf16_t)(pk2(v, 0.f) & 0xffffu);
    }
}

DI void phase_prep(const Params& p, float* smem) {
  const int n_ain = 2 * 16 * 10, n_aout = 2 * 16 * 4, n_bin = 2 * 16 * 16, n_bout = 2 * 16 * 4;
  const int total = n_ain + n_aout + n_bin + n_bout + 192 + 1;
  for (int item = blockIdx.x; item < total; item += gridDim.x) {
    int it = item;
    if (it < n_ain) { int l = it / 160, r = it % 160; prep_transpose_item(p.a_w_in + (size_t)l * 1024 * 2560, p.wt_a_in + (size_t)l * 2560 * 1024, 2560, r / 10, r % 10, smem); continue; }
    it -= n_ain;
    if (it < n_aout) { int l = it / 64, r = it % 64; prep_transpose_item(p.a_w_out + (size_t)l * 1024 * 1024, p.wt_a_out + (size_t)l * 1024 * 1024, 1024, r / 4, r % 4, smem); continue; }
    it -= n_aout;
    if (it < n_bin) { int l = it / 256, r = it % 256; prep_transpose_item(p.b_w_in + (size_t)l * 1024 * 4096, p.wt_b_in + (size_t)l * 4096 * 1024, 4096, r / 16, r % 16, smem); continue; }
    it -= n_bin;
    if (it < n_bout) { int l = it / 64, r = it % 64; prep_transpose_item(p.b_w_out + (size_t)l * 1024 * 1024, p.wt_b_out + (size_t)l * 1024 * 1024, 1024, r / 4, r % 4, smem); continue; }
    it -= n_bout;
    if (it < 192) { prep_mod_item(p, it, smem); continue; }
    for (int e = opaque_tid(); e < 64 * 16; e += NTHR) {
      int pos = e >> 4, j = e & 15;
      float inv = powf(10000.0f, -(float)j / 16.0f);
      float ang = (float)pos * inv;
      p.rope[e * 2 + 0] = cosf(ang);
      p.rope[e * 2 + 1] = sinf(ang);
    }
  }
}

DI void mod0_row(const float* src, bf16_t* dst, int c0, const float4 sc0, const float4 sc1, const float4 sc2, const float4 sc3,
                 const float4 sh0, const float4 sh1, const float4 sh2, const float4 sh3) {
  const f32x4 v0 = __builtin_nontemporal_load((const f32x4*)(src + c0)), v1 = __builtin_nontemporal_load((const f32x4*)(src + c0 + 256));
  const f32x4 v2 = __builtin_nontemporal_load((const f32x4*)(src + c0 + 512)), v3 = __builtin_nontemporal_load((const f32x4*)(src + c0 + 768));
  uint2 o;
  o.x = pk2(v0[0] * (1.f + sc0.x) + sh0.x, v0[1] * (1.f + sc0.y) + sh0.y); o.y = pk2(v0[2] * (1.f + sc0.z) + sh0.z, v0[3] * (1.f + sc0.w) + sh0.w);
  *(uint2*)(dst + c0) = o;
  o.x = pk2(v1[0] * (1.f + sc1.x) + sh1.x, v1[1] * (1.f + sc1.y) + sh1.y); o.y = pk2(v1[2] * (1.f + sc1.z) + sh1.z, v1[3] * (1.f + sc1.w) + sh1.w);
  *(uint2*)(dst + c0 + 256) = o;
  o.x = pk2(v2[0] * (1.f + sc2.x) + sh2.x, v2[1] * (1.f + sc2.y) + sh2.y); o.y = pk2(v2[2] * (1.f + sc2.z) + sh2.z, v2[3] * (1.f + sc2.w) + sh2.w);
  *(uint2*)(dst + c0 + 512) = o;
  o.x = pk2(v3[0] * (1.f + sc3.x) + sh3.x, v3[1] * (1.f + sc3.y) + sh3.y); o.y = pk2(v3[2] * (1.f + sc3.z) + sh3.z, v3[3] * (1.f + sc3.w) + sh3.w);
  *(uint2*)(dst + c0 + 768) = o;
}
DI void phase_mod0(const Params& p) {
  const int tid = opaque_tid(), lane = tid & 63, wave = __builtin_amdgcn_readfirstlane(tid >> 6);
  const int c0 = lane * 4;
  const int nw = gridDim.x * 8, gw = blockIdx.x * 8 + wave;
  const int r_lo = (int)(((long)gw * TT) / nw), r_hi = (int)(((long)(gw + 1) * TT) / nw);
  int bcur = -1;
  float4 sc0, sc1, sc2, sc3, sh0, sh1, sh2, sh3;
  sc0 = sc1 = sc2 = sc3 = sh0 = sh1 = sh2 = sh3 = make_float4(0.f, 0.f, 0.f, 0.f);
#pragma unroll 1
  for (int row = r_lo; row < r_hi; ++row) {
    const bool isctx = row >= TL;
    const int b = isctx ? 32 : (row >> 11);
    if (b != bcur) {
      bcur = b;
      const float* md = p.mod + (size_t)b * 3072;
      sh0 = *(const float4*)(md + c0); sh1 = *(const float4*)(md + c0 + 256); sh2 = *(const float4*)(md + c0 + 512); sh3 = *(const float4*)(md + c0 + 768);
      sc0 = *(const float4*)(md + 1024 + c0); sc1 = *(const float4*)(md + 1024 + c0 + 256); sc2 = *(const float4*)(md + 1024 + c0 + 512); sc3 = *(const float4*)(md + 1024 + c0 + 768);
    }
    const float* srcp = isctx ? (p.ctx + (size_t)(row - TL) * 1024) : (p.x + (size_t)row * 1024);
    mod0_row(srcp, p.u + (size_t)row * 1024, c0, sc0, sc1, sc2, sc3, sh0, sh1, sh2, sh3);
  }
}

namespace pg8 {
#define PG8_LAS __attribute__((address_space(3)))
constexpr int BM = 256, BK = 64, HALF = 128, HTB = HALF * BK * 2, STAGE_BYTES = 8 * HTB, NXCD = 8, WGM = 8;
DI int lds_byte(int r, int c) { const int st = (r >> 4) * 2 + (c >> 5), rr = r & 15, cc = c & 31, ob = rr * 64 + cc * 2; return st * 1024 + (ob ^ (((ob >> 9) & 1) << 5)); }
DI void stage_rc(int b, int& R, int& C) { const int st = b / 1024, sb = b % 1024, swz = sb ^ (((sb >> 9) & 1) << 5); R = (st >> 1) * 16 + swz / 64; C = (st & 1) * 32 + (swz % 64) / 2; }
DI int perm32(int rho) { const int n = rho >> 4, i = rho & 15; return 8 * (i >> 2) + 4 * n + (i & 3); }
struct Unit { int pm, pn; };
struct Gemm { const bf16_t* A; const bf16_t* Bt; int M, N, K, lda; };
struct StaticOrder {
  int nM, nN, nwg, G, c;
  DI void init(int M, int N, int G_, int c_) { nM = M / BM; nN = N / BM; nwg = nM * nN; G = G_; c = c_; }
  DI bool next(int i, Unit& u) const {
    const long L = (long)i * G + c; if (L >= nwg) return false;
    int wgid = (int)L; { const int q = nwg / NXCD, r = nwg % NXCD, xcd = wgid % NXCD, off = wgid / NXCD; wgid = (xcd < r ? xcd * (q + 1) : r * (q + 1) + (xcd - r) * q) + off; }
    const int nig = WGM * nN, gid = wgid / nig, fm = gid * WGM, gsz = (nM - fm) < WGM ? (nM - fm) : WGM;
    u.pm = fm + ((wgid % nig) % gsz); u.pn = (wgid % nig) / gsz; return true;
  }
};

template <class Epi>
DI void gemm_phase(PG8_LAS unsigned char* lds, const Gemm g, const StaticOrder& S, const Epi& E) {
  const int tid = opaque_tid(), wid = __builtin_amdgcn_readfirstlane(tid >> 6), lane = tid & 63, wr = wid >> 2, wc = wid & 3, fr = lane & 15, fq = lane >> 4;
  const int K = g.K, nt = K / BK, lda = g.lda;
  unsigned voffA[2], voffB[2];
#pragma unroll
  for (int i = 0; i < 2; ++i) { int R, C; stage_rc(tid * 16 + i * 8192, R, C); const int Rb = Epi::PERM ? ((R & ~31) + perm32(R & 31)) : R;
    voffA[i] = (unsigned)(R * lda + C) * 2u; voffB[i] = (unsigned)(Rb * K + C) * 2u; }
  const size_t kstep = (size_t)(BK * 2);
  const size_t hstepA = (size_t)HALF * lda * 2, hstepB = (size_t)HALF * K * 2;
  const size_t tstepA = 2 * hstepA, tstepB = 2 * hstepB;
  const unsigned ldsw = (unsigned)wid * 1024u;
  const int aoff = lds_byte(wr * 64 + fr, fq * 8), boff = lds_byte(wc * 32 + fr, fq * 8);
#define PG8_SA(b, h) (((b) * 2 + (h)) * HTB)
#define PG8_SB(b, h) ((4 + (b) * 2 + (h)) * HTB)
#define PG8_STAGE(bufoff, gbase, voff) do { _Pragma("unroll") for (int _i = 0; _i < 2; ++_i) \
    __builtin_amdgcn_global_load_lds((const unsigned*)((const char*)(gbase) + (voff)[_i]), (PG8_LAS unsigned*)(lds + (bufoff) + ldsw + _i * 8192), 16, 0, 0); } while (0)
#define PG8_LDA(dst, b, h) do { _Pragma("unroll") for (int m = 0; m < 4; ++m) _Pragma("unroll") for (int k = 0; k < 2; ++k) dst[m][k] = *(const PG8_LAS bf16x8*)(lds + PG8_SA(b, h) + aoff + m * 2048 + k * 1024); } while (0)
#define PG8_LDB(dst, b, h) do { _Pragma("unroll") for (int n = 0; n < 2; ++n) _Pragma("unroll") for (int k = 0; k < 2; ++k) dst[n][k] = *(const PG8_LAS bf16x8*)(lds + PG8_SB(b, h) + boff + n * 2048 + k * 1024); } while (0)
#define PG8_MMA(ai, bj, At, Bt) do { __builtin_amdgcn_s_setprio(1); _Pragma("unroll") for (int m = 0; m < 4; ++m) _Pragma("unroll") for (int n = 0; n < 2; ++n) _Pragma("unroll") for (int k = 0; k < 2; ++k) \
    acc[ai][bj][m][n] = __builtin_amdgcn_mfma_f32_16x16x32_bf16(Bt[n][k], At[m][k], acc[ai][bj][m][n], 0, 0, 0); __builtin_amdgcn_s_setprio(0); } while (0)
#define PG8_WAIT_V(n) asm volatile("s_waitcnt vmcnt(" #n ")" ::: "memory")
#define PG8_WAIT_L(n) asm volatile("s_waitcnt lgkmcnt(" #n ")" ::: "memory")
#define PG8_BAR __builtin_amdgcn_s_barrier()
#define PG8_SCHED __builtin_amdgcn_sched_barrier(0)
  Unit cur, nxt; int ui = 0;
  if (!S.next(0, cur)) return;
  f32x4 acc[2][2][4][2];
#pragma unroll
  for (int a = 0; a < 2; ++a)
#pragma unroll
    for (int b = 0; b < 2; ++b)
#pragma unroll
      for (int m = 0; m < 4; ++m)
#pragma unroll
        for (int n = 0; n < 2; ++n) acc[a][b][m][n] = (f32x4){0.f, 0.f, 0.f, 0.f};
  bf16x8 At[4][2], B0[2][2], B1[2][2];
  const char* cA = (const char*)g.A + (size_t)cur.pm * tstepA; const char* cB = (const char*)g.Bt + (size_t)cur.pn * tstepB;
  PG8_STAGE(PG8_SB(0, 0), cB, voffB); PG8_STAGE(PG8_SA(0, 0), cA, voffA); PG8_STAGE(PG8_SB(0, 1), cB + hstepB, voffB); PG8_STAGE(PG8_SA(0, 1), cA + hstepA, voffA);
  if (wr == 1) PG8_BAR;
  PG8_WAIT_V(4); PG8_BAR;
  PG8_STAGE(PG8_SB(1, 0), cB + kstep, voffB); PG8_STAGE(PG8_SA(1, 0), cA + kstep, voffA); PG8_STAGE(PG8_SB(1, 1), cB + hstepB + kstep, voffB);
  PG8_WAIT_V(6); PG8_BAR;
  for (;;) {
    const bool has_next = S.next(ui + 1, nxt);
    const char* nA = has_next ? (const char*)g.A + (size_t)nxt.pm * tstepA : cA; const char* nB = has_next ? (const char*)g.Bt + (size_t)nxt.pn * tstepB : cB;
    for (int t = 0; t < nt; t += 2) {
      const bool last = (t == nt - 2);
      const char* a1 = cA + (size_t)(t + 1) * kstep;
      const char* a2 = last ? nA : cA + (size_t)(t + 2) * kstep; const char* b2 = last ? nB : cB + (size_t)(t + 2) * kstep;
      const char* a3 = a2 + kstep; const char* b3 = b2 + kstep;
      PG8_LDB(B0, 0, 0); PG8_SCHED; PG8_LDA(At, 0, 0); PG8_STAGE(PG8_SA(1, 1), a1 + hstepA, voffA);
      PG8_WAIT_L(8); PG8_BAR; PG8_WAIT_L(0); PG8_MMA(0, 0, At, B0); PG8_BAR; PG8_SCHED;
      PG8_LDB(B1, 0, 1); PG8_STAGE(PG8_SB(0, 0), b2, voffB);
      PG8_BAR; PG8_WAIT_L(0); PG8_MMA(0, 1, At, B1); PG8_BAR;
      PG8_LDA(At, 0, 1); PG8_STAGE(PG8_SA(0, 0), a2, voffA);
      PG8_BAR; PG8_WAIT_L(0); PG8_MMA(1, 0, At, B0); PG8_BAR; PG8_SCHED;
      PG8_STAGE(PG8_SB(0, 1), b2 + hstepB, voffB);
      PG8_WAIT_V(6); PG8_BAR; PG8_MMA(1, 1, At, B1); PG8_BAR;
      PG8_LDB(B0, 1, 0); PG8_SCHED; PG8_LDA(At, 1, 0); PG8_STAGE(PG8_SA(0, 1), a2 + hstepA, voffA);
      PG8_WAIT_L(8); PG8_BAR; PG8_WAIT_L(0); PG8_MMA(0, 0, At, B0); PG8_BAR; PG8_SCHED;
      PG8_LDB(B1, 1, 1); PG8_STAGE(PG8_SB(1, 0), b3, voffB);
      PG8_BAR; PG8_WAIT_L(0); PG8_MMA(0, 1, At, B1); PG8_BAR;
      PG8_LDA(At, 1, 1); PG8_STAGE(PG8_SA(1, 0), a3, voffA);
      PG8_BAR; PG8_WAIT_L(0); PG8_MMA(1, 0, At, B0); PG8_BAR; PG8_SCHED;
      PG8_STAGE(PG8_SB(1, 1), b3 + hstepB, voffB);
      PG8_WAIT_V(6); PG8_BAR; PG8_MMA(1, 1, At, B1); PG8_BAR;
    }
    E(acc, cur, wr, wc, fr, fq);
    if (!has_next) break;
#pragma unroll
    for (int a = 0; a < 2; ++a)
#pragma unroll
      for (int b = 0; b < 2; ++b)
#pragma unroll
        for (int m = 0; m < 4; ++m)
#pragma unroll
          for (int n = 0; n < 2; ++n) acc[a][b][m][n] = (f32x4){0.f, 0.f, 0.f, 0.f};
    cur = nxt; cA = nA; cB = nB; ++ui;
  }
  PG8_WAIT_V(0);
  if (wr == 0) PG8_BAR;
  PG8_BAR;
#undef PG8_SA
#undef PG8_SB
#undef PG8_STAGE
#undef PG8_LDA
#undef PG8_LDB
#undef PG8_MMA
#undef PG8_WAIT_V
#undef PG8_WAIT_L
#undef PG8_BAR
#undef PG8_SCHED
}
}

template <int MODE>
struct EpiMk {
  static constexpr bool PERM = true;
  bf16_t* u; bf16_t* qkvg; LAS3 const float* rope;
  int pm_off, pn_off;
  DI void operator()(const f32x4 (&acc)[2][2][4][2], const pg8::Unit& un, int wr, int wc, int fr, int fq) const {
    constexpr bool isA = (MODE == 0);
    constexpr int NW = isA ? 2560 : 4096, kend = isA ? 1280 : 2048, vend = isA ? 1536 : 3072;
    const int upm = un.pm + pm_off, upn = un.pn + pn_off;
    const bool isctx = upm >= 256;
#pragma unroll
    for (int ai = 0; ai < 2; ++ai)
#pragma unroll
      for (int m = 0; m < 4; ++m) {
        const int row = upm * 256 + ai * 128 + wr * 64 + m * 16 + fr;
#pragma unroll
        for (int bj = 0; bj < 2; ++bj) {
          const int c128 = upn * 256 + bj * 128;
          const int col0 = c128 + wc * 32 + fq * 8;
          f32x4 v0 = acc[ai][bj][m][0], v1 = acc[ai][bj][m][1];
          if (MODE == 2) {
            u32x4 w; w[0] = pk2(v0[0], v0[1]); w[1] = pk2(v0[2], v0[3]); w[2] = pk2(v1[0], v1[1]); w[3] = pk2(v1[2], v1[3]);
            *(u32x4*)(u + (size_t)row * 1024 + col0) = w;
          } else {
            if (isA && !isctx && c128 < kend) {
              f32x4 p0, p1;
#pragma unroll
              for (int e = 0; e < 4; ++e) { p0[e] = __shfl_xor(v0[e], 32); p1[e] = __shfl_xor(v1[e], 32); }
              const int sp = row & 2047;
              const int pos = (wc & 1) ? (sp & 63) : (sp >> 6);
              LAS3 const float* tb = rope + (pos * 16 + 8 * (fq & 1)) * 2;
              const f32x4 t0 = *(LAS3 const f32x4*)(tb), t1 = *(LAS3 const f32x4*)(tb + 4), t2 = *(LAS3 const f32x4*)(tb + 8), t3 = *(LAS3 const f32x4*)(tb + 12);
              const float sg = (fq < 2) ? -1.f : 1.f;
              v0[0] = v0[0] * t0[0] + sg * p0[0] * t0[1]; v0[1] = v0[1] * t0[2] + sg * p0[1] * t0[3];
              v0[2] = v0[2] * t1[0] + sg * p0[2] * t1[1]; v0[3] = v0[3] * t1[2] + sg * p0[3] * t1[3];
              v1[0] = v1[0] * t2[0] + sg * p1[0] * t2[1]; v1[1] = v1[1] * t2[2] + sg * p1[1] * t2[3];
              v1[2] = v1[2] * t3[0] + sg * p1[2] * t3[1]; v1[3] = v1[3] * t3[2] + sg * p1[3] * t3[3];
            }
            if (c128 >= vend) {
#pragma unroll
              for (int e = 0; e < 4; ++e) { v0[e] = silu_f(v0[e]); v1[e] = silu_f(v1[e]); }
            } else if (c128 < 1024) {
              v0 = v0 * (0.125f * 1.4426950408889634f); v1 = v1 * (0.125f * 1.4426950408889634f);
            }
            u32x4 w; w[0] = pk2(v0[0], v0[1]); w[1] = pk2(v0[2], v0[3]); w[2] = pk2(v1[0], v1[1]); w[3] = pk2(v1[2], v1[3]);
            *(u32x4*)(qkvg + (size_t)row * NW + col0) = w;
          }
        }
      }
  }
};

template <int MODE>
DI void gemm_phase(const Params& p, const bf16_t* A, int lda, const bf16_t* Wt, int M, int N, char* smem, int pm_off = 0, int pn_off = 0) {
  pg8::Gemm g; g.A = A; g.Bt = Wt; g.M = M; g.N = N; g.K = 1024; g.lda = lda;
  pg8::StaticOrder S; S.init(M, N, (int)gridDim.x, (int)blockIdx.x);
  LAS3 float* ropel = (LAS3 float*)((LAS3 char*)smem + 131072);
  if (MODE == 0) {
    const int tid = opaque_tid();
    for (int e = tid; e < 64 * 16 * 2; e += NTHR) ropel[e] = p.rope[e];
    __syncthreads();
  }
  EpiMk<MODE> E{p.u, p.qkvg, ropel, pm_off, pn_off};
  pg8::gemm_phase(( PG8_LAS unsigned char*)smem, g, S, E);
  __syncthreads();
}
enum { EPI_A = 0, EPI_B = 1, EPI_OUT = 2 };

typedef short s16x4 __attribute__((ext_vector_type(4)));
constexpr int ATT_STAGE = 32768, ATT_NST = 3;
constexpr int ATT_GATE = ATT_NST * ATT_STAGE;
constexpr int ATT_TAB = ATT_GATE + 32768;
constexpr int TAB_NH = 4, TAB_HEAD0 = 32, TAB_HSTR = 480, TAB_NEG = 32 + TAB_NH * 480 + 64, TAB_FLOATS = TAB_NEG + 128;
constexpr float LOG2E = 1.4426950408889634f;
DI int crow(int v, int h) { return (v & 3) + 8 * (v >> 2) + 4 * h; }
DI int swz(int row) { return (((row >> 1) & 1) << 2) | ((row >> 2) & 3); }
DI bf16x8 tr_pair(LAS3 const char* plo, LAS3 const char* phi) {
  const s16x4 lo = __builtin_amdgcn_ds_read_tr16_b64_v4i16((LAS3 s16x4*)(plo));
  const s16x4 hi = __builtin_amdgcn_ds_read_tr16_b64_v4i16((LAS3 s16x4*)(phi));
  return __builtin_shufflevector(lo, hi, 0, 1, 2, 3, 4, 5, 6, 7);
}
struct AttnLane { int kr0, kr1, kr2, kr3, vr00, vr01, vr10, vr11; };
DI f32x16 qk_tile(LAS3 const char* kb, const AttnLane& L, const bf16x8& q0, const bf16x8& q1, const bf16x8& q2, const bf16x8& q3, const f32x16& init) {
  f32x16 s = __builtin_amdgcn_mfma_f32_32x32x16_bf16(*(LAS3 const bf16x8*)(kb + L.kr0), q0, init, 0, 0, 0);
  s = __builtin_amdgcn_mfma_f32_32x32x16_bf16(*(LAS3 const bf16x8*)(kb + L.kr1), q1, s, 0, 0, 0);
  s = __builtin_amdgcn_mfma_f32_32x32x16_bf16(*(LAS3 const bf16x8*)(kb + L.kr2), q2, s, 0, 0, 0);
  s = __builtin_amdgcn_mfma_f32_32x32x16_bf16(*(LAS3 const bf16x8*)(kb + L.kr3), q3, s, 0, 0, 0);
  return s;
}
DI void pv_tile(LAS3 const char* vb, const AttnLane& L, const f32x16& pr, f32x16& o0, f32x16& o1) {
  u32x4 w0, w1;
  w0[0] = pk2(pr[0], pr[1]); w0[1] = pk2(pr[2], pr[3]); w0[2] = pk2(pr[4], pr[5]); w0[3] = pk2(pr[6], pr[7]);
  w1[0] = pk2(pr[8], pr[9]); w1[1] = pk2(pr[10], pr[11]); w1[2] = pk2(pr[12], pr[13]); w1[3] = pk2(pr[14], pr[15]);
  const bf16x8 pf0 = __builtin_bit_cast(bf16x8, w0), pf1 = __builtin_bit_cast(bf16x8, w1);
  o0 = __builtin_amdgcn_mfma_f32_32x32x16_bf16(tr_pair(vb + L.vr00, vb + L.vr01), pf0, o0, 0, 0, 0);
  o1 = __builtin_amdgcn_mfma_f32_32x32x16_bf16(tr_pair(vb + L.vr10, vb + L.vr11), pf0, o1, 0, 0, 0);
  o0 = __builtin_amdgcn_mfma_f32_32x32x16_bf16(tr_pair(vb + 2048 + L.vr00, vb + 2048 + L.vr01), pf1, o0, 0, 0, 0);
  o1 = __builtin_amdgcn_mfma_f32_32x32x16_bf16(tr_pair(vb + 2048 + L.vr10, vb + 2048 + L.vr11), pf1, o1, 0, 0, 0);
}

struct AttnSt { f32x16 o0, o1, cinit; float m, l; };

template <int MK>
DI void attn_chunk(LAS3 const char* k0, LAS3 const char* k1, LAS3 const char* v0, LAS3 const char* v1, const AttnLane& L,
                   const bf16x8& q0, const bf16x8& q1, const bf16x8& q2, const bf16x8& q3,
                   AttnSt& st, const f32x16& init, const int h, const int kb0, const int kb1, const int sq, LAS3 const float* b0, LAS3 const float* b1) {
  f32x16 s0 = qk_tile(k0, L, q0, q1, q2, q3, init);
  f32x16 s1 = qk_tile(k1, L, q0, q1, q2, q3, init);
  if (MK == 2) {
#pragma unroll
    for (int v = 0; v < 16; ++v) { s0[v] += b0[(v & 3) + 8 * (v >> 2)]; s1[v] += b1[(v & 3) + 8 * (v >> 2)]; }
  }
  if (MK == 1 && kb1 != 0x7fffffff) {
    const int lo = max(0, sq - 128), hi = min(2047, sq + 128);
    const int L0 = lo - kb0 - 4 * h, H0 = hi - kb0 - 4 * h, L1 = lo - kb1 - 4 * h, H1 = hi - kb1 - 4 * h;
#pragma unroll
    for (int v = 0; v < 16; ++v) {
      const int cv = (v & 3) + 8 * (v >> 2);
      s0[v] = (cv >= L0 && cv <= H0) ? s0[v] : -1e30f;
      s1[v] = (cv >= L1 && cv <= H1) ? s1[v] : -1e30f;
    }
  }
#pragma unroll
  for (int v = 0; v < 16; ++v) s0[v] = __builtin_amdgcn_exp2f(s0[v]);
  const float a0 = (s0[0] + s0[1]) + (s0[2] + s0[3]), a1 = (s0[4] + s0[5]) + (s0[6] + s0[7]);
  const float a2 = (s0[8] + s0[9]) + (s0[10] + s0[11]), a3 = (s0[12] + s0[13]) + (s0[14] + s0[15]);
  pv_tile(v0, L, s0, st.o0, st.o1);
#pragma unroll
  for (int v = 0; v < 16; ++v) s1[v] = __builtin_amdgcn_exp2f(s1[v]);
  const float a4 = (s1[0] + s1[1]) + (s1[2] + s1[3]), a5 = (s1[4] + s1[5]) + (s1[6] + s1[7]);
  const float a6 = (s1[8] + s1[9]) + (s1[10] + s1[11]), a7 = (s1[12] + s1[13]) + (s1[14] + s1[15]);
  pv_tile(v1, L, s1, st.o0, st.o1);
  const float sum = ((a0 + a1) + (a2 + a3)) + ((a4 + a5) + (a6 + a7));
  st.l += sum;
  const float tot = sum + __shfl_xor(sum, 32);
  if (__builtin_amdgcn_ballot_w64(tot > 256.f) != 0) {
    const float delta = fmaxf(__builtin_amdgcn_logf(tot), 0.f);
    const float alpha = __builtin_amdgcn_exp2f(-delta);
    st.m += delta; st.l *= alpha;
#pragma unroll
    for (int v = 0; v < 16; ++v) { st.cinit[v] -= delta; st.o0[v] *= alpha; st.o1[v] *= alpha; }
  }
}

struct ItemD { int b, hk, nt, a0, a1; };
template <int MODE> DI ItemD item_desc(int item) {
  ItemD d; d.a0 = 0; d.a1 = 0;
  if (MODE == 0) { d.b = item >> 7; d.hk = (item >> 5) & 3; d.a0 = (item & 31) * 64 - 128; d.nt = 5; }
  else if (MODE == 1) {
    d.b = item >> 7; d.hk = (item >> 3) & 15; const int r0 = (item & 7) * 4;
    d.a0 = clampi(r0 - 4, 0, 24); d.a1 = clampi(r0 - 1, 0, 24) + 7; d.nt = 2 + ((d.a1 - d.a0 + 2) >> 1);
  } else if (MODE == 2) { d.b = item >> 4; d.hk = (item >> 2) & 3; d.nt = 2; }
  else { d.b = item >> 4; d.hk = item & 15; d.nt = 2; }
  return d;
}

template <int MODE>
DI void attn_seq(const Params& p, int layer, char* smem, const int tid, const int nitems, bf16_t* ob, const int ostride) {
  constexpr bool isA = (MODE == 0 || MODE == 2);
  constexpr bool isLat = (MODE < 2);
  constexpr int NW = isA ? 2560 : 4096, koff = 1024, voff = isA ? 1280 : 2048, goff = isA ? 1536 : 3072;
  const int jl = layer >> 1;
  const int lane = tid & 63, wv = __builtin_amdgcn_readfirstlane(tid >> 6), r = lane & 31, h = lane >> 5;
  const int item0 = (int)(((long)blockIdx.x * nitems) / (long)gridDim.x);
  const int nit = (int)(((long)(blockIdx.x + 1) * nitems) / (long)gridDim.x) - item0;
  if (nit <= 0) return;
  LAS3 char* lds = (LAS3 char*)smem;
  LAS3 const float* tab = (LAS3 const float*)(lds + ATT_TAB);
  const int hq_first = (MODE == 1) ? ((item0 >> 3) & 15) : 0;
  if (MODE == 1) {
    LAS3 float* tabw = (LAS3 float*)(lds + ATT_TAB);
    __syncthreads();
    for (int e = tid; e < TAB_FLOATS; e += NTHR) {
      float v = 0.f;
      const int t = e - TAB_HEAD0;
      if (t >= 0 && t < TAB_NH * TAB_HSTR) { const int hh = hq_first + t / TAB_HSTR, w = t % TAB_HSTR; if (w < 465 && hh < 16) v = p.b_rel_bias[((size_t)jl * 16 + hh) * 465 + w] * LOG2E; }
      if (e >= TAB_NEG) v = -1e30f;
      tabw[e] = v;
    }
  }
  const int cs_blk = (MODE == 1) ? clampi(16 * (wv & 3) - 8, 0, 32) : 0;
  auto make_lane = [&](const int cs) {
    AttnLane L;
    const int rr = r + cs, sw = swz(rr & 15);
    L.kr0 = rr * 128 + ((0 + h) ^ sw) * 16; L.kr1 = rr * 128 + ((2 + h) ^ sw) * 16; L.kr2 = rr * 128 + ((4 + h) ^ sw) * 16; L.kr3 = rr * 128 + ((6 + h) ^ sw) * 16;
    const int q = (lane & 15) >> 2, pp = lane & 3, g = (lane >> 4) & 1;
    const int ra = cs + 4 * h + q, rb = ra + 8;
    const int lp0 = 2 * g + (pp >> 1), lp1 = 4 + lp0;
    L.vr00 = ra * 128 + ((lp0 ^ swz(ra & 15)) * 16) + 8 * (pp & 1); L.vr01 = rb * 128 + ((lp0 ^ swz(rb & 15)) * 16) + 8 * (pp & 1);
    L.vr10 = ra * 128 + ((lp1 ^ swz(ra & 15)) * 16) + 8 * (pp & 1); L.vr11 = rb * 128 + ((lp1 ^ swz(rb & 15)) * 16) + 8 * (pp & 1);
    return L;
  };
  const int drow = 8 * wv + (lane >> 3);
  const int dlp = ((lane & 7) ^ swz(drow & 15)) * 8;
  auto issue = [&](const ItemD& d, int u, int stage) {
#pragma unroll
    for (int c = 0; c < 2; ++c) {
      int tok;
      if (u < 2) tok = TL + d.b * 256 + (2 * u + c) * 64 + drow;
      else if (MODE == 0) tok = d.b * 2048 + clampi(d.a0 + 64 * (2 * (u - 2) + c) + drow, 0, 2047);
      else tok = d.b * 2048 + min(d.a0 + 2 * (u - 2) + c, d.a1) * 64 + drow;
      const bf16_t* g = p.qkvg + (size_t)tok * NW + d.hk * 64 + dlp;
      __builtin_amdgcn_global_load_lds((const unsigned*)(g + koff), (LAS3 unsigned*)(lds + stage * ATT_STAGE + c * 8192 + wv * 1024), 16, 0, 0);
      __builtin_amdgcn_global_load_lds((const unsigned*)(g + voff), (LAS3 unsigned*)(lds + stage * ATT_STAGE + 16384 + c * 8192 + wv * 1024), 16, 0, 0);
    }
  };
  int gk = 0, gu = 0;
  ItemD gd = item_desc<MODE>(item0);
  int sa = 0;
  bool gvalid = true;
  auto gen_issue = [&]() {
    issue(gd, gu, sa);
    sa = (sa == ATT_NST - 1) ? 0 : sa + 1;
    if (++gu == gd.nt) { gu = 0; ++gk; if (gk < nit) gd = item_desc<MODE>(item0 + gk); else gvalid = false; }
  };
  __syncthreads();
  gen_issue();
  if (gvalid) gen_issue();
  int sc = 0, slast = 0;
  constexpr bool QPF = (MODE != 1);
  auto q_ptr = [&](int item) -> const bf16_t* {
    const ItemD e = item_desc<MODE>(item);
    int hq_, tq_;
    if (MODE == 0) { hq_ = e.hk * 4 + (wv & 3); tq_ = e.b * 2048 + (item & 31) * 64 + 32 * (wv >> 2) + r; }
    else if (MODE == 1) { hq_ = e.hk; tq_ = e.b * 2048 + ((item & 7) * 4 + 2 * (wv >> 2) + (r >> 4)) * 64 + 16 * (wv & 3) + (r & 15); }
    else if (MODE == 2) { hq_ = e.hk * 4 + (wv & 3); tq_ = TL + e.b * 256 + (item & 3) * 64 + 32 * (wv >> 2) + r; }
    else { hq_ = e.hk; tq_ = TL + e.b * 256 + wv * 32 + r; }
    return p.qkvg + (size_t)tq_ * NW + hq_ * 64 + h * 8;
  };
  bf16x8 qn0 = {}, qn1 = {}, qn2 = {}, qn3 = {};
  if (QPF) { const bf16_t* qp = q_ptr(item0); qn0 = *(const bf16x8*)(qp); qn1 = *(const bf16x8*)(qp + 16); qn2 = *(const bf16x8*)(qp + 32); qn3 = *(const bf16x8*)(qp + 48); }
#pragma unroll 1
  for (int k = 0; k < nit; ++k) {
    const int item = item0 + k;
    const ItemD d = item_desc<MODE>(item);
    int hq, tq, q0i = 0, rq = 0, cq = 0, wr_lo = 0, wr_hi = 0;
    if (MODE == 0) { hq = d.hk * 4 + (wv & 3); q0i = (item & 31) * 64 + 32 * (wv >> 2); tq = d.b * 2048 + q0i + r; }
    else if (MODE == 1) {
      hq = d.hk; const int rw = (item & 7) * 4 + 2 * (wv >> 2);
      rq = rw + (r >> 4); cq = 16 * (wv & 3) + (r & 15); tq = d.b * 2048 + rq * 64 + cq;
      wr_lo = clampi(rw - 4, 0, 24); wr_hi = clampi(rw - 3, 0, 24) + 7;
    } else if (MODE == 2) { hq = d.hk * 4 + (wv & 3); tq = TL + d.b * 256 + (item & 3) * 64 + 32 * (wv >> 2) + r; }
    else { hq = d.hk; tq = TL + d.b * 256 + wv * 32 + r; }
    {
#pragma unroll
      for (int pass = 0; pass < 4; ++pass) {
        const int row = (lane >> 3) + 8 * pass;
        int tqr;
        if (MODE == 0) tqr = d.b * 2048 + q0i + row;
        else if (MODE == 1) tqr = d.b * 2048 + ((item & 7) * 4 + 2 * (wv >> 2) + (row >> 4)) * 64 + 16 * (wv & 3) + (row & 15);
        else if (MODE == 2) tqr = TL + d.b * 256 + (item & 3) * 64 + 32 * (wv >> 2) + row;
        else tqr = TL + d.b * 256 + wv * 32 + row;
        __builtin_amdgcn_global_load_lds((const unsigned*)(p.qkvg + (size_t)tqr * NW + goff + hq * 64 + (lane & 7) * 8),
                                         (LAS3 unsigned*)(lds + ATT_GATE + wv * 4096 + pass * 1024), 16, 0, 0);
      }
    }
    bf16x8 q0f, q1f, q2f, q3f;
    if (QPF) { q0f = qn0; q1f = qn1; q2f = qn2; q3f = qn3; }
    else { const bf16_t* qp = p.qkvg + (size_t)tq * NW + hq * 64 + h * 8; q0f = *(const bf16x8*)(qp); q1f = *(const bf16x8*)(qp + 16); q2f = *(const bf16x8*)(qp + 32); q3f = *(const bf16x8*)(qp + 48); }
    AttnSt st;
#pragma unroll
    for (int v = 0; v < 16; ++v) {
      st.o0[v] = 0.f; st.o1[v] = 0.f;
      float ci = 0.f;
      if (MODE == 1) {
        const int cs_q = clampi(cq - 8, 0, 48);
        const int kc = cs_blk + crow(v, h);
        ci = (kc >= cs_q && kc < cs_q + 16) ? 0.f : -1e30f;
      }
      st.cinit[v] = ci;
    }
    st.m = 0.f; st.l = 0.f;
    const int colbase = cs_blk - cq + 15 + 4 * h;
#pragma unroll 1
    for (int u = 0; u < d.nt; ++u) {
      if (gvalid || !(k == nit - 1 && u == d.nt - 1)) asm volatile("s_waitcnt vmcnt(4)" ::: "memory");
      else asm volatile("s_waitcnt vmcnt(0)" ::: "memory");
      __builtin_amdgcn_s_barrier();
      asm volatile("" ::: "memory");
      if (gvalid) gen_issue();
      if (QPF && u == d.nt - 1 && k + 1 < nit) {
        const bf16_t* qp = q_ptr(item + 1);
        qn0 = *(const bf16x8*)(qp); qn1 = *(const bf16x8*)(qp + 16); qn2 = *(const bf16x8*)(qp + 32); qn3 = *(const bf16x8*)(qp + 48);
      }
      LAS3 const char* Kb = lds + sc * ATT_STAGE;
      LAS3 const char* Vb = Kb + 16384;
      slast = sc;
      sc = (sc == ATT_NST - 1) ? 0 : sc + 1;
      const AttnLane L = make_lane((MODE == 1 && u >= 2) ? cs_blk : 0);
      if (MODE == 0) {
#pragma unroll 1
        for (int c = 0; c < 2; ++c) {
          int kb0 = 0, kb1 = 0x7fffffff;
          if (u >= 2) {
            const int kbc = d.a0 + 64 * (2 * (u - 2) + c);
            if (kbc + 63 < 0 || kbc >= 2048 || kbc > q0i + 159 || kbc + 63 < q0i - 128) continue;
            const bool need_mask = (kbc < 0) || (kbc + 63 >= 2048) || (kbc < q0i + 31 - 128) || (kbc + 63 > q0i + 128);
            if (need_mask) { kb0 = kbc; kb1 = kbc + 32; }
          }
          attn_chunk<1>(Kb + c * 64 * 128, Kb + (c * 64 + 32) * 128, Vb + c * 64 * 128, Vb + (c * 64 + 32) * 128, L,
                        q0f, q1f, q2f, q3f, st, st.cinit, h, kb0, kb1, q0i + r, nullptr, nullptr);
        }
      } else if (!isLat || u < 2) {
#pragma unroll 1
        for (int c = 0; c < 2; ++c) {
          if (MODE == 1) {
            f32x16 cm;
#pragma unroll
            for (int v = 0; v < 16; ++v) cm[v] = -st.m;
            attn_chunk<0>(Kb + c * 64 * 128, Kb + (c * 64 + 32) * 128, Vb + c * 64 * 128, Vb + (c * 64 + 32) * 128, L,
                          q0f, q1f, q2f, q3f, st, cm, h, 0, 0, 0, nullptr, nullptr);
          } else {
            attn_chunk<0>(Kb + c * 64 * 128, Kb + (c * 64 + 32) * 128, Vb + c * 64 * 128, Vb + (c * 64 + 32) * 128, L,
                          q0f, q1f, q2f, q3f, st, st.cinit, h, 0, 0, 0, nullptr, nullptr);
          }
        }
      } else if (MODE == 1) {
        const int rrA = d.a0 + 2 * (u - 2), rrB = rrA + 1;
        const bool inA = (rrA >= wr_lo) && (rrA <= wr_hi), inB = (rrB >= wr_lo) && (rrB <= wr_hi) && (rrB <= d.a1);
        if (inA || inB) {
          const int rs_q = clampi(rq - 4, 0, 24);
          const bool okA = (rrA >= rs_q) && (rrA < rs_q + 8), okB = (rrB >= rs_q) && (rrB < rs_q + 8) && (rrB <= d.a1);
          LAS3 const float* bA = (okA ? (tab + TAB_HEAD0 + (hq - hq_first) * TAB_HSTR + (rrA - rq + 7) * 31) : (tab + TAB_NEG + 32)) + colbase;
          LAS3 const float* bB = (okB ? (tab + TAB_HEAD0 + (hq - hq_first) * TAB_HSTR + (rrB - rq + 7) * 31) : (tab + TAB_NEG + 32)) + colbase;
          attn_chunk<2>(Kb, Kb + 64 * 128, Vb, Vb + 64 * 128, L, q0f, q1f, q2f, q3f, st, st.cinit, h, 0, 0, 0, bA, bB);
        }
      }
    }
    float lsum = st.l + __shfl_xor(st.l, 32);
    if (isA) lsum += __builtin_amdgcn_exp2f(p.a_sink[jl * 16 + hq] * LOG2E - st.m);
    const float inv = 1.f / lsum;
    LAS3 char* scr = lds + ATT_GATE + wv * 4096;
    u32x4 gv0, gv1, gv2, gv3;
    gv0 = *(LAS3 const u32x4*)(scr + 0 * 1024 + lane * 16); gv1 = *(LAS3 const u32x4*)(scr + 1 * 1024 + lane * 16);
    gv2 = *(LAS3 const u32x4*)(scr + 2 * 1024 + lane * 16); gv3 = *(LAS3 const u32x4*)(scr + 3 * 1024 + lane * 16);
    asm volatile("s_waitcnt lgkmcnt(0)" ::: "memory");
    {
      const int swr = swz(r & 15);
#pragma unroll
      for (int g4 = 0; g4 < 4; ++g4) {
        u32x2 w0, w1;
        w0[0] = pk2(st.o0[4 * g4 + 0] * inv, st.o0[4 * g4 + 1] * inv); w0[1] = pk2(st.o0[4 * g4 + 2] * inv, st.o0[4 * g4 + 3] * inv);
        w1[0] = pk2(st.o1[4 * g4 + 0] * inv, st.o1[4 * g4 + 1] * inv); w1[1] = pk2(st.o1[4 * g4 + 2] * inv, st.o1[4 * g4 + 3] * inv);
        *(LAS3 u32x2*)(scr + r * 128 + ((g4 ^ swr) * 16) + 8 * h) = w0;
        *(LAS3 u32x2*)(scr + r * 128 + (((4 + g4) ^ swr) * 16) + 8 * h) = w1;
      }
    }
#pragma unroll
    for (int pass = 0; pass < 4; ++pass) {
      const int row = (lane >> 3) + 8 * pass, piece = lane & 7;
      const u32x4 ov = *(LAS3 const u32x4*)(scr + row * 128 + ((piece ^ swz(row & 15)) * 16));
      int tqr;
      if (MODE == 0) tqr = d.b * 2048 + q0i + row;
      else if (MODE == 1) tqr = d.b * 2048 + ((item & 7) * 4 + 2 * (wv >> 2) + (row >> 4)) * 64 + 16 * (wv & 3) + (row & 15);
      else if (MODE == 2) tqr = TL + d.b * 256 + (item & 3) * 64 + 32 * (wv >> 2) + row;
      else tqr = TL + d.b * 256 + wv * 32 + row;
      const u32x4 gv = (pass == 0) ? gv0 : (pass == 1) ? gv1 : (pass == 2) ? gv2 : gv3;
      uint4 w;
      w.x = pk2(bflo(ov[0]) * bflo(gv[0]), bfhi(ov[0]) * bfhi(gv[0]));
      w.y = pk2(bflo(ov[1]) * bflo(gv[1]), bfhi(ov[1]) * bfhi(gv[1]));
      w.z = pk2(bflo(ov[2]) * bflo(gv[2]), bfhi(ov[2]) * bfhi(gv[2]));
      w.w = pk2(bflo(ov[3]) * bflo(gv[3]), bfhi(ov[3]) * bfhi(gv[3]));
      *(uint4*)(ob + (size_t)tqr * ostride + hq * 64 + piece * 8) = w;
    }
    asm volatile("s_waitcnt lgkmcnt(0)" ::: "memory");
  }
}

DI void attn_phase(const Params& p, int layer, char* smem, bf16_t* ob, const int ostride) {
  const bool isA = !(layer & 1);
  const bool ctx_out = layer < 3;
  if (isA) {
    { const int tid = opaque_tid(); attn_seq<0>(p, layer, smem, tid, 4096, ob, ostride); }
    if (ctx_out) { const int tid = opaque_tid(); attn_seq<2>(p, layer, smem, tid, 512, ob, ostride); }
  } else {
    { const int tid = opaque_tid(); attn_seq<1>(p, layer, smem, tid, 4096, ob, ostride); }
    if (ctx_out) { const int tid = opaque_tid(); attn_seq<3>(p, layer, smem, tid, 512, ob, ostride); }
  }
  __syncthreads();
}

#define XB_TMO      128
#define XB_XCNT(j)  (256  + 64 * (j))
#define XB_XSUB(j)  (1280 + 64 * (j))
#define XB_XGEN(j)  (2304 + 64 * (j))
#define XB_TOP      3328
#define XB_TOPGEN   3392
#define XCD_BAR_WORDS 3456
#define XB_SPIN_CAP (1u << 18)
DI unsigned xb_ld(unsigned* p)              { return __hip_atomic_load(p, __ATOMIC_RELAXED, __HIP_MEMORY_SCOPE_AGENT); }
DI unsigned xb_add(unsigned* p, unsigned v) { return __hip_atomic_fetch_add(p, v, __ATOMIC_RELAXED, __HIP_MEMORY_SCOPE_AGENT); }
DI unsigned xb_xcc_id() { return (unsigned)__builtin_amdgcn_s_getreg((3 << 11) | 20) & 0xFu; }
#define XB_SPIN(cond, bar) do { unsigned _sp = 0; while (cond) { __builtin_amdgcn_s_sleep(1); \
    if ((++_sp & 255u) == 0u) { if (xb_ld(&(bar)[XB_TMO])) break; if (_sp > XB_SPIN_CAP) { atomicAdd(&(bar)[XB_TMO], 1u); break; } } } } while (0)
DI void xcd_barrier_post(unsigned* bar) { if (threadIdx.x == 0) (void)xb_add(&bar[XB_XCNT(xb_xcc_id())], 1u); }
DI void xcd_barrier_complete(unsigned* bar, unsigned x, unsigned& nloc, unsigned& nx) {
  const unsigned G = gridDim.x;
  unsigned sum, cnt, mine, sp = 0u;
  for (;;) {
    sum = 0u; cnt = 0u; mine = 0u;
#pragma unroll
    for (unsigned j = 0; j < 16; ++j) { const unsigned c = xb_ld(&bar[XB_XCNT(j)]); sum += c; cnt += (c > 0u) ? 1u : 0u; mine = (j == x) ? c : mine; }
    if (sum == G) break;
    __builtin_amdgcn_s_sleep(1);
    if ((++sp & 255u) == 0u) { if (xb_ld(&bar[XB_TMO])) break; if (sp > XB_SPIN_CAP) { atomicAdd(&bar[XB_TMO], 1u); break; } }
  }
  nloc = mine > 0u ? mine : 1u; nx = cnt > 0u ? cnt : 1u;
}
DI void xcd_barrier(unsigned* bar, volatile LAS3 unsigned* st) {
  asm volatile("s_waitcnt vmcnt(0)" ::: "memory");
  __syncthreads();
  if (threadIdx.x == 0) {
    const unsigned x = xb_xcc_id();
    __builtin_amdgcn_s_waitcnt(0);
    unsigned nloc = st[0], nx = st[1];
    if (nloc == 0u) { xcd_barrier_complete(bar, x, nloc, nx); st[0] = nloc; st[1] = nx; }
    const unsigned old = xb_add(&bar[XB_XSUB(x)], 1u);
    const unsigned gen = old / nloc;
    if (old + 1u == (gen + 1u) * nloc) {
      __builtin_amdgcn_fence(__ATOMIC_RELEASE, "agent");
      asm volatile("s_waitcnt vmcnt(0)" ::: "memory");
      const unsigned og = xb_add(&bar[XB_TOP], 1u);
      const unsigned tg = og / nx;
      if (og + 1u == (tg + 1u) * nx) xb_add(&bar[XB_TOPGEN], 1u);
      else XB_SPIN(xb_ld(&bar[XB_TOPGEN]) == tg, bar);
      __builtin_amdgcn_fence(__ATOMIC_ACQUIRE, "agent");
      xb_add(&bar[XB_XGEN(x)], 1u);
      asm volatile("s_waitcnt vmcnt(0)" ::: "memory");
    } else {
      XB_SPIN(xb_ld(&bar[XB_XGEN(x)]) == gen, bar);
      __builtin_amdgcn_fence(__ATOMIC_ACQUIRE, "agent");
      asm volatile("s_waitcnt vmcnt(0)" ::: "memory");
    }
  }
  __syncthreads();
}

typedef _Float16 h16x2 __attribute__((ext_vector_type(2)));
DI unsigned pkh2(float lo, float hi) { f32x2 v = {lo, hi}; return __builtin_bit_cast(unsigned, __builtin_convertvector(v, h16x2)); }
DI float hlo(unsigned u) { return (float)__builtin_bit_cast(h16x2, u)[0]; }
DI float hhi(unsigned u) { return (float)__builtin_bit_cast(h16x2, u)[1]; }
struct LnVec { float4 a, b, c, d; };
DI LnVec ln_ldvec(const float* v, int c0) { LnVec r; r.a = *(const float4*)(v + c0); r.b = *(const float4*)(v + c0 + 4); r.c = *(const float4*)(v + 512 + c0); r.d = *(const float4*)(v + 512 + c0 + 4); return r; }
DI float4 ld_nt4(const float* p) { const f32x4 v = __builtin_nontemporal_load((const f32x4*)p); return make_float4(v[0], v[1], v[2], v[3]); }
DI float4 h4lo(const u32x4 v) { return make_float4(hlo(v[0]), hhi(v[0]), hlo(v[1]), hhi(v[1])); }
DI float4 h4hi(const u32x4 v) { return make_float4(hlo(v[2]), hhi(v[2]), hlo(v[3]), hhi(v[3])); }
DI float4 b4lo(const uint4 v) { return make_float4(bflo(v.x), bfhi(v.x), bflo(v.y), bfhi(v.y)); }
DI float4 b4hi(const uint4 v) { return make_float4(bflo(v.z), bfhi(v.z), bflo(v.w), bfhi(v.w)); }
DI float4 zmix(const float4 h, const float4 g, const float4 y) { return make_float4(ALPHA * h.x + g.x * y.x, ALPHA * h.y + g.y * y.y, ALPHA * h.z + g.z * y.z, ALPHA * h.w + g.w * y.w); }
DI float sq4(float4 z, float mean) {
  float a = z.x - mean, b = z.y - mean, c = z.z - mean, d = z.w - mean;
  return a * a + b * b + c * c + d * d;
}
struct LnRow { float4 z0, z1, z2, z3; };
template <bool IN16>
DI LnRow ln_load(const float* hin, const unsigned short* hin16, const bf16_t* yu, const LnVec& gate, int c0) {
  LnRow r;
  const uint4 ya = *(const uint4*)(yu + c0), yb = *(const uint4*)(yu + 512 + c0);
  float4 h0, h1, h2, h3;
  if (IN16) {
    const u32x4 ha = __builtin_nontemporal_load((const u32x4*)(hin16 + c0)), hb = __builtin_nontemporal_load((const u32x4*)(hin16 + 512 + c0));
    h0 = h4lo(ha); h1 = h4hi(ha); h2 = h4lo(hb); h3 = h4hi(hb);
  } else {
    h0 = ld_nt4(hin + c0); h1 = ld_nt4(hin + c0 + 4); h2 = ld_nt4(hin + 512 + c0); h3 = ld_nt4(hin + 512 + c0 + 4);
  }
  r.z0 = zmix(h0, gate.a, b4lo(ya)); r.z1 = zmix(h1, gate.b, b4hi(ya)); r.z2 = zmix(h2, gate.c, b4lo(yb)); r.z3 = zmix(h3, gate.d, b4hi(yb));
  return r;
}
DI float4 ln_norm(const float4 z, float mean, float rstd, const float4 g, const float4 b) {
  return make_float4((z.x - mean) * rstd * g.x + b.x, (z.y - mean) * rstd * g.y + b.y, (z.z - mean) * rstd * g.z + b.z, (z.w - mean) * rstd * g.w + b.w);
}
DI unsigned umod(float a, float b, float sca, float scb, float sha, float shb) { return pk2(a * (1.f + sca) + sha, b * (1.f + scb) + shb); }
template <bool OUT16>
DI void ln_finish(const LnRow& r, float* hout, unsigned short* hout16, bf16_t* yu, const LnVec& g, const LnVec& b, const LnVec& sc, const LnVec& sh, int c0, bool wr_u) {
  const float sum = (r.z0.x + r.z0.y + r.z0.z + r.z0.w) + (r.z1.x + r.z1.y + r.z1.z + r.z1.w) + (r.z2.x + r.z2.y + r.z2.z + r.z2.w) + (r.z3.x + r.z3.y + r.z3.z + r.z3.w);
  const float mean = wave_sum(sum) * (1.f / 1024.f);
  const float sq = sq4(r.z0, mean) + sq4(r.z1, mean) + sq4(r.z2, mean) + sq4(r.z3, mean);
  const float rstd = rsqrtf(wave_sum(sq) * (1.f / 1024.f) + 1e-5f);
  const float4 o0 = ln_norm(r.z0, mean, rstd, g.a, b.a), o1 = ln_norm(r.z1, mean, rstd, g.b, b.b), o2 = ln_norm(r.z2, mean, rstd, g.c, b.c), o3 = ln_norm(r.z3, mean, rstd, g.d, b.d);
  if (OUT16) {
    u32x4 wa, wb;
    wa[0] = pkh2(o0.x, o0.y); wa[1] = pkh2(o0.z, o0.w); wa[2] = pkh2(o1.x, o1.y); wa[3] = pkh2(o1.z, o1.w);
    wb[0] = pkh2(o2.x, o2.y); wb[1] = pkh2(o2.z, o2.w); wb[2] = pkh2(o3.x, o3.y); wb[3] = pkh2(o3.z, o3.w);
    __builtin_nontemporal_store(wa, (u32x4*)(hout16 + c0));
    __builtin_nontemporal_store(wb, (u32x4*)(hout16 + 512 + c0));
  } else {
    f32x4 v;
    v[0] = o0.x; v[1] = o0.y; v[2] = o0.z; v[3] = o0.w; __builtin_nontemporal_store(v, (f32x4*)(hout + c0));
    v[0] = o1.x; v[1] = o1.y; v[2] = o1.z; v[3] = o1.w; __builtin_nontemporal_store(v, (f32x4*)(hout + c0 + 4));
    v[0] = o2.x; v[1] = o2.y; v[2] = o2.z; v[3] = o2.w; __builtin_nontemporal_store(v, (f32x4*)(hout + 512 + c0));
    v[0] = o3.x; v[1] = o3.y; v[2] = o3.z; v[3] = o3.w; __builtin_nontemporal_store(v, (f32x4*)(hout + 512 + c0 + 4));
  }
  if (wr_u) {
    uint4 ua, ub;
    ua.x = umod(o0.x, o0.y, sc.a.x, sc.a.y, sh.a.x, sh.a.y); ua.y = umod(o0.z, o0.w, sc.a.z, sc.a.w, sh.a.z, sh.a.w);
    ua.z = umod(o1.x, o1.y, sc.b.x, sc.b.y, sh.b.x, sh.b.y); ua.w = umod(o1.z, o1.w, sc.b.z, sc.b.w, sh.b.z, sh.b.w);
    ub.x = umod(o2.x, o2.y, sc.c.x, sc.c.y, sh.c.x, sh.c.y); ub.y = umod(o2.z, o2.w, sc.c.z, sc.c.w, sh.c.z, sh.c.w);
    ub.z = umod(o3.x, o3.y, sc.d.x, sc.d.y, sh.d.x, sh.d.y); ub.w = umod(o3.z, o3.w, sc.d.z, sc.d.w, sh.d.z, sh.d.w);
    *(uint4*)(yu + c0) = ua;
    *(uint4*)(yu + 512 + c0) = ub;
  }
}
template <bool IN16, bool OUT16>
DI void ln_body(const Params& p, int layer) {
  const int tid = opaque_tid(), lane = tid & 63, wave = __builtin_amdgcn_readfirstlane(tid >> 6);
  const int nrows = (layer < 3) ? TT : TL;
  const bool wr_u = layer < 3;
  const int c0 = lane * 8;
  const float* lgp = p.ln_g + layer * 1024;
  const float* lbp = p.ln_b + layer * 1024;
  const int nw = gridDim.x * 8, gw = blockIdx.x * 8 + wave;
  const int r_lo = (int)(((long)gw * nrows) / nw), r_hi = (int)(((long)(gw + 1) * nrows) / nw);
  constexpr bool in16 = IN16, out16 = OUT16;
  int bcur = -1;
  LnVec gate = ln_ldvec(lgp, c0);
  const float* md2 = p.mod;
#pragma unroll 1
  for (int row = r_lo; row < r_hi; row += 4) {
    const int nr = min(4, r_hi - row);
    const int bq = (row >= TL) ? 32 : (row >> 11);
    const int bl = (row + nr - 1 >= TL) ? 32 : ((row + nr - 1) >> 11);
    if (bq != bl || nr < 4) {
      for (int j = 0; j < nr; ++j) {
        const int rj = row + j;
        const bool isctx = rj >= TL;
        const int b = isctx ? 32 : (rj >> 11);
        if (b != bcur) {
          bcur = b;
          const float* md = p.mod + ((size_t)layer * 33 + b) * 3072;
          md2 = p.mod + ((size_t)(wr_u ? layer + 1 : layer) * 33 + b) * 3072;
          gate = ln_ldvec(md + 2048, c0);
        }
        const float* hin = isctx ? (p.ctx + (size_t)(rj - TL) * 1024) : (p.x + (size_t)rj * 1024);
        const unsigned short* hin16 = in16 ? (p.h16 + (size_t)rj * 1024) : nullptr;
        float* hout = p.out + (size_t)(isctx ? 0 : rj) * 1024;
        unsigned short* hout16 = out16 ? (p.h16 + (size_t)rj * 1024) : nullptr;
        bf16_t* yu = p.u + (size_t)rj * 1024;
        const LnRow ra = ln_load<IN16>(hin, hin16, yu, gate, c0);
        const LnVec g = ln_ldvec(lgp, c0), bb = ln_ldvec(lbp, c0), sc = ln_ldvec(md2 + 1024, c0), sh = ln_ldvec(md2, c0);
        ln_finish<OUT16>(ra, hout, hout16, yu, g, bb, sc, sh, c0, wr_u);
      }
      continue;
    }
    if (bq != bcur) {
      bcur = bq;
      const float* md = p.mod + ((size_t)layer * 33 + bq) * 3072;
      md2 = p.mod + ((size_t)(wr_u ? layer + 1 : layer) * 33 + bq) * 3072;
      gate = ln_ldvec(md + 2048, c0);
    }
    const bool isctx = row >= TL;
    const float* hin = isctx ? (p.ctx + (size_t)(row - TL) * 1024) : (p.x + (size_t)row * 1024);
    const unsigned short* hin16 = in16 ? (p.h16 + (size_t)row * 1024) : nullptr;
    float* hout = p.out + (size_t)(isctx ? 0 : row) * 1024;
    unsigned short* hout16 = out16 ? (p.h16 + (size_t)row * 1024) : nullptr;
    bf16_t* yu = p.u + (size_t)row * 1024;
    const unsigned short* hb = hin16 ? hin16 + 1024 : nullptr; const unsigned short* hc_ = hin16 ? hin16 + 2048 : nullptr; const unsigned short* hd = hin16 ? hin16 + 3072 : nullptr;
    const LnRow ra = ln_load<IN16>(hin, hin16, yu, gate, c0), rb = ln_load<IN16>(hin + 1024, hb, yu + 1024, gate, c0), rc = ln_load<IN16>(hin + 2048, hc_, yu + 2048, gate, c0), rd = ln_load<IN16>(hin + 3072, hd, yu + 3072, gate, c0);
    const LnVec g = ln_ldvec(lgp, c0), bb = ln_ldvec(lbp, c0), sc = ln_ldvec(md2 + 1024, c0), sh = ln_ldvec(md2, c0);
    ln_finish<OUT16>(ra, hout, hout16, yu, g, bb, sc, sh, c0, wr_u);
    ln_finish<OUT16>(rb, hout + 1024, hout16 ? hout16 + 1024 : nullptr, yu + 1024, g, bb, sc, sh, c0, wr_u);
    ln_finish<OUT16>(rc, hout + 2048, hout16 ? hout16 + 2048 : nullptr, yu + 2048, g, bb, sc, sh, c0, wr_u);
    ln_finish<OUT16>(rd, hout + 3072, hout16 ? hout16 + 3072 : nullptr, yu + 3072, g, bb, sc, sh, c0, wr_u);
  }
}

DI void ln_phase(const Params& p, int layer) {
  if (layer == 0) ln_body<false, true>(p, layer);
  else if (layer < 3) ln_body<true, true>(p, layer);
  else ln_body<true, false>(p, layer);
}

__global__ void __launch_bounds__(512, 2) mega(Params p, int ph_lo, int ph_hi) {
  extern __shared__ __attribute__((aligned(16))) char smem[];
  volatile LAS3 unsigned* bst = (volatile LAS3 unsigned*)(smem + SMEM_BAR);
  if (ph_hi - ph_lo > 1) {
    if (threadIdx.x == 0) { bst[0] = 0u; bst[1] = 0u; }
    __syncthreads();
    xcd_barrier_post(p.bar);
  }
  for (int ph = ph_lo; ph < ph_hi; ++ph) {
    if (ph == 0) phase_prep(p, (float*)smem);
    else if (ph == 1) phase_mod0(p);
    else {
      const int layer = (ph - 2) >> 2, sub = (ph - 2) & 3;
      const bool isA = !(layer & 1);
      const int jl = layer >> 1;
      const int NW = isA ? 2560 : 4096;
      if (sub == 0) {
        if (isA) gemm_phase<EPI_A>(p, p.u, 1024, p.wt_a_in + (size_t)jl * 2560 * 1024, TT, 2560, smem);
        else if (layer < 3) gemm_phase<EPI_B>(p, p.u, 1024, p.wt_b_in + (size_t)jl * 4096 * 1024, TT, 4096, smem);
        else {
          gemm_phase<EPI_B>(p, p.u, 1024, p.wt_b_in + (size_t)jl * 4096 * 1024, TL, 4096, smem);
          gemm_phase<EPI_B>(p, p.u + (size_t)TL * 1024, 1024, p.wt_b_in + (size_t)jl * 4096 * 1024 + (size_t)1024 * 1024, TC, 2048, smem, 256, 4);
        }
      } else if (sub == 1) {
        attn_phase(p, layer, smem, p.qkvg + (isA ? 1536 : 3072), NW);
      } else if (sub == 2) {
        const int M = (layer < 3) ? TT : TL;
        const int goff = isA ? 1536 : 3072;
        gemm_phase<EPI_OUT>(p, p.qkvg + goff, NW, (isA ? p.wt_a_out : p.wt_b_out) + (size_t)jl * 1024 * 1024, M, 1024, smem);
      } else {
        ln_phase(p, layer);
      }
    }
    if (ph + 1 < ph_hi) { if (ph_hi > 1000) cg::this_grid().sync(); else xcd_barrier(p.bar, bst); }
  }
}

extern "C" void kernel_launch(void* const* d_in, const int* in_sizes, int n_in, void* d_out, int out_size, void* d_ws, size_t ws_size,
                              hipStream_t stream) {
  static int grid_blocks = 0;
  if (!grid_blocks) {
    int dev = 0, cus = 0, per_cu = 0;
    (void)hipGetDevice(&dev);
    (void)hipDeviceGetAttribute(&cus, hipDeviceAttributeMultiprocessorCount, dev);
    (void)hipFuncSetAttribute((const void*)mega, hipFuncAttributeMaxDynamicSharedMemorySize, SMEM_BYTES);
    (void)hipOccupancyMaxActiveBlocksPerMultiprocessor(&per_cu, mega, NTHR, SMEM_BYTES);
    if (per_cu < 1) per_cu = 1;
    grid_blocks = cus * per_cu;
  }
  Params p{};
  p.x = (const float*)d_in[0]; p.c = (const float*)d_in[1]; p.ctx = (const float*)d_in[2]; p.c_ctx = (const float*)d_in[3];
  p.w_ada = (const float*)d_in[4]; p.b_ada = (const float*)d_in[5]; p.ln_g = (const float*)d_in[6]; p.ln_b = (const float*)d_in[7];
  p.a_w_in = (const float*)d_in[8]; p.a_w_out = (const float*)d_in[9]; p.a_sink = (const float*)d_in[10];
  p.b_w_in = (const float*)d_in[11]; p.b_w_out = (const float*)d_in[12]; p.b_rel_bias = (const float*)d_in[13];
  p.out = (float*)d_out;
  char* w = (char*)d_ws;
  size_t off = 0;
  auto take = [&](size_t bytes) { char* r = w + off; off += (bytes + 255) & ~(size_t)255; return r; };
  p.hc = (float*)take((size_t)TC * 1024 * 4);
  p.u = (bf16_t*)take((size_t)TT * 1024 * 2);
  p.qkvg = (bf16_t*)take((size_t)TT * 4096 * 2);
  p.h16 = (unsigned short*)take((size_t)TT * 1024 * 2);
  p.wt_a_in = (bf16_t*)take((size_t)2 * 2560 * 1024 * 2);
  p.wt_a_out = (bf16_t*)take((size_t)2 * 1024 * 1024 * 2);
  p.wt_b_in = (bf16_t*)take((size_t)2 * 4096 * 1024 * 2);
  p.wt_b_out = (bf16_t*)take((size_t)2 * 1024 * 1024 * 2);
  p.mod = (float*)take((size_t)5 * 33 * 3072 * 4);
  p.rope = (float*)take((size_t)64 * 16 * 2 * 4);
  p.bar = (unsigned*)take((size_t)XCD_BAR_WORDS * 4);
  if (off > ws_size) { fprintf(stderr, "workspace too small: need %zu have %zu\n", off, ws_size); return; }
#if MK_COOP
  (void)hipMemsetAsync(p.bar, 0, (size_t)XCD_BAR_WORDS * 4, stream);
  int lo = 0, hi = NPHASE;
  void* args[] = {&p, &lo, &hi};
  hipError_t e = hipLaunchCooperativeKernel((void*)mega, dim3(grid_blocks), dim3(NTHR), args, SMEM_BYTES, stream);
  if (e != hipSuccess) fprintf(stderr, "cooperative launch failed: %s (grid %d)\n", hipGetErrorString(e), grid_blocks);
#else
  for (int ph = 0; ph < NPHASE; ++ph) hipLaunchKernelGGL(mega, dim3(grid_blocks), dim3(NTHR), SMEM_BYTES, stream, p, ph, ph + 1);
#endif
}
```
